# Optimizing an MI355X kernel written in HIP

```python
import jax, jax.numpy as jnp
from jax import lax
import numpy as np

D_MODEL = 1024
BATCH = 8
SEQ = 4096
DEPTH = 2

EXPAND = 2
D_INNER = EXPAND * D_MODEL
D_POOL = D_INNER // 2
D_SB = D_INNER - D_POOL
POOL_WINDOWS = (2, 4, 8, 16)
N_POOL_GROUPS = len(POOL_WINDOWS)
POOL_GROUP = D_POOL // N_POOL_GROUPS
SB_HEAD_DIM = 64
SB_HEADS = D_SB // SB_HEAD_DIM
SB_BLOCK = 128
CONV_WIDTH = 3
D_CONV = D_INNER
D_IN_EVEN = D_POOL + 3 * D_SB + D_INNER
D_IN_ODD = 3 * D_CONV + D_INNER
N_EVEN = (DEPTH + 1) // 2
N_ODD = DEPTH // 2
EPS = 1e-6

kernel_name = "hybrid_pool_stickbreak_shortconv_adaln"


def rmsnorm(x, g):
    xf = x.astype(jnp.float32)
    y = xf * lax.rsqrt(jnp.mean(xf * xf, axis=-1, keepdims=True) + EPS)
    return (y * g.astype(jnp.float32)).astype(x.dtype)


def adaln_params(c, w, b):
    m = jax.nn.silu(c) @ w + b
    shift, scale, gate = jnp.split(m, 3, axis=-1)
    return shift[:, None, :], scale[:, None, :], gate[:, None, :]


def pool_mixer(u, w_grp, scale):
    bsz, s, _ = u.shape
    uf = u.astype(jnp.float32)
    cs = jnp.cumsum(uf, axis=1)
    pos = jnp.arange(s, dtype=jnp.float32)
    outs = []
    for gi, w in enumerate(POOL_WINDOWS):
        sl = slice(gi * POOL_GROUP, (gi + 1) * POOL_GROUP)
        cg = cs[..., sl]
        prev = jnp.pad(cg, ((0, 0), (w, 0), (0, 0)))[:, :s]
        count = jnp.minimum(pos + 1.0, float(w))[None, :, None]
        outs.append((cg - prev) / count - uf[..., sl])
    p = jnp.stack(outs, axis=2).astype(u.dtype)
    y = jnp.einsum('bsgc,gcd->bsgd', p, w_grp).reshape(bsz, s, D_POOL)
    return y * scale


def stick_breaking_attention(q, k, v):
    bsz, s, _, _ = q.shape
    qh, kh, vh = (jnp.swapaxes(t, 1, 2) for t in (q, k, v))
    inv_sqrt = 1.0 / np.sqrt(SB_HEAD_DIM).astype(np.float32)
    outs = []
    for blk in range(s // SB_BLOCK):
        q0 = blk * SB_BLOCK
        end = q0 + SB_BLOCK
        qb = qh[:, :, q0:end]
        kb = kh[:, :, :end]
        vb = vh[:, :, :end]
        z = jnp.einsum('bhqd,bhkd->bhqk', qb, kb).astype(jnp.float32) * inv_sqrt
        q_pos = jnp.arange(q0, end)[:, None]
        k_pos = jnp.arange(end)[None, :]
        causal = k_pos < q_pos
        log_fail = jnp.where(causal, -jax.nn.softplus(z), 0.0)
        after = lax.cumsum(log_fail, axis=3, reverse=True) - log_fail
        a = jnp.where(causal, jnp.exp(jax.nn.log_sigmoid(z) + after), 0.0)
        outs.append(jnp.einsum('bhqk,bhkd->bhqd', a.astype(vb.dtype), vb))
    o = jnp.concatenate(outs, axis=2)
    return jnp.swapaxes(o, 1, 2).reshape(bsz, s, SB_HEADS * SB_HEAD_DIM)


def even_mixer(h, w_in, pool_w, pool_scale, w_out):
    bsz, s, _ = h.shape
    proj = h @ w_in
    u_pool, q, k, v, gate = jnp.split(
        proj, [D_POOL, D_POOL + D_SB, D_POOL + 2 * D_SB, D_POOL + 3 * D_SB], axis=-1)
    y_pool = pool_mixer(u_pool, pool_w, pool_scale)
    shp = (bsz, s, SB_HEADS, SB_HEAD_DIM)
    y_sb = stick_breaking_attention(q.reshape(shp), k.reshape(shp), v.reshape(shp))
    y = jnp.concatenate([y_pool, y_sb], axis=-1) * jax.nn.silu(gate)
    return y @ w_out


def odd_mixer(h, w_in, conv_w, conv_b, w_out):
    s = h.shape[1]
    proj = h @ w_in
    gb, gc, u, gate = jnp.split(proj, [D_CONV, 2 * D_CONV, 3 * D_CONV], axis=-1)
    u = gc * u
    up = jnp.pad(u, ((0, 0), (CONV_WIDTH - 1, 0), (0, 0)))
    conv = conv_b + sum(up[:, j:j + s] * conv_w[j] for j in range(CONV_WIDTH))
    y = gb * conv * jax.nn.silu(gate)
    return y @ w_out


def setup_inputs(seed: int = 0) -> dict:
    key = jax.random.key(seed)
    ks = jax.random.split(key, 16)
    f32 = jnp.float32
    D = D_MODEL
    nrm = lambda k, shp, sc: jax.random.normal(k, shp, f32) * sc
    return {
        "x": nrm(ks[0], (BATCH, SEQ, D), 1.0),
        "c": nrm(ks[1], (BATCH, D), 1.0),
        "norm_g": 1.0 + nrm(ks[2], (DEPTH, D), 0.02),
        "ada_w": nrm(ks[3], (DEPTH, D, 3 * D), 0.1 * D ** -0.5),
        "ada_b": nrm(ks[4], (DEPTH, 3 * D), 0.01),
        "even_w_in": nrm(ks[5], (N_EVEN, D, D_IN_EVEN), D ** -0.5),
        "pool_w": nrm(ks[6], (N_EVEN, N_POOL_GROUPS, POOL_GROUP, POOL_GROUP), POOL_GROUP ** -0.5),
        "pool_scale": 1.0 + nrm(ks[7], (N_EVEN, D_POOL), 0.02),
        "even_w_out": nrm(ks[8], (N_EVEN, D_INNER, D), D_INNER ** -0.5),
        "odd_w_in": nrm(ks[9], (N_ODD, D, D_IN_ODD), D ** -0.5),
        "conv_w": nrm(ks[10], (N_ODD, CONV_WIDTH, D_CONV), CONV_WIDTH ** -0.5),
        "conv_b": nrm(ks[11], (N_ODD, D_CONV), 0.01),
        "odd_w_out": nrm(ks[12], (N_ODD, D_INNER, D), D_INNER ** -0.5),
        "final_g": 1.0 + nrm(ks[13], (D,), 0.02),
    }


def reference(x, c, norm_g, ada_w, ada_b, even_w_in, pool_w, pool_scale, even_w_out,
              odd_w_in, conv_w, conv_b, odd_w_out, final_g):
    for i in range(DEPTH):
        shift, scale, gate = adaln_params(c, ada_w[i], ada_b[i])
        h = rmsnorm(x, norm_g[i]) * (1.0 + scale) + shift
        j = i // 2
        if i % 2 == 0:
            y = even_mixer(h, even_w_in[j], pool_w[j], pool_scale[j], even_w_out[j])
        else:
            y = odd_mixer(h, odd_w_in[j], conv_w[j], conv_b[j], odd_w_out[j])
        x = x + ((1.0 + gate) * y).astype(x.dtype)
    return rmsnorm(x, final_g)
```

```cpp
#include <hip/hip_runtime.h>
#include <hip/hip_cooperative_groups.h>
#include <cstdio>
#include <cstdint>
namespace pg8 {
#define PG8_LAS __attribute__((address_space(3)))
typedef unsigned short bf16_t;
typedef short bf16x8 __attribute__((ext_vector_type(8)));
typedef float f32x4 __attribute__((ext_vector_type(4)));
typedef unsigned u32x4 __attribute__((ext_vector_type(4)));
constexpr int BM = 256, BK = 64, HALF = 128, HTB = HALF * BK * 2  , STAGE_BYTES = 8 * HTB, NXCD = 8, WGM = 8;

__host__ __device__ __forceinline__ int lds_byte(int r, int c) { const int st = (r >> 4) * 2 + (c >> 5), rr = r & 15, cc = c & 31, ob = rr * 64 + cc * 2; return st * 1024 + (ob ^ (((ob >> 9) & 1) << 5)); }
__host__ __device__ __forceinline__ void stage_rc(int b, int& R, int& C) { const int st = b / 1024, sb = b % 1024, swz = sb ^ (((sb >> 9) & 1) << 5); R = (st >> 1) * 16 + swz / 64; C = (st & 1) * 32 + (swz % 64) / 2; }
__host__ __device__ __forceinline__ int perm32(int rho) { const int n = rho >> 4, i = rho & 15; return 8 * (i >> 2) + 4 * n + (i & 3); }

struct Unit { int pm, pn; };
struct Gemm { const bf16_t* A; const bf16_t* Bt; int M, N, K; };

struct StaticOrder {
    int nM, nN, nwg, G, c;
    __host__ __device__ void init(int M, int N, int G_, int c_) { nM = M / BM; nN = N / BM; nwg = nM * nN; G = G_; c = c_; }
    __host__ __device__ bool next(int i, Unit& u) const {
        const long L = (long)i * G + c; if (L >= nwg) return false;
        int wgid = (int)L; { const int q = nwg / NXCD, r = nwg % NXCD, xcd = wgid % NXCD, off = wgid / NXCD; wgid = (xcd < r ? xcd * (q + 1) : r * (q + 1) + (xcd - r) * q) + off; }
        const int nig = WGM * nN, gid = wgid / nig, fm = gid * WGM, gsz = (nM - fm) < WGM ? (nM - fm) : WGM;
        u.pm = fm + ((wgid % nig) % gsz); u.pn = (wgid % nig) / gsz; return true;
    }
    __device__ __forceinline__ void a_ready(const Unit&) const {}
    __device__ __forceinline__ void done(const Unit&) const {}
};
__device__ __forceinline__ unsigned cvt_pk_bf16(float lo, float hi) { unsigned r; asm volatile("v_cvt_pk_bf16_f32 %0, %1, %2" : "=v"(r) : "v"(lo), "v"(hi)); return r; }
template <class Epi, class Sched, bool ALIGN_EPI = false, bool SP2 = false>
__device__ __forceinline__ void gemm_phase(PG8_LAS unsigned char* lds, const Gemm g, const Sched& S, const Epi& E) {
    const int tid = threadIdx.x, wid = __builtin_amdgcn_readfirstlane(tid >> 6), lane = tid & 63, wr = wid >> 2, wc = wid & 3, fr = lane & 15, fq = lane >> 4;
    const int K = g.K, nt = K / BK;
    unsigned voffA[2], voffB[2];
#pragma unroll
    for (int i = 0; i < 2; ++i) { int R, C; stage_rc(tid * 16 + i * 8192, R, C); const int Rb = Epi::PERM ? ((R & ~31) + perm32(R & 31)) : R;
        voffA[i] = (unsigned)(R * K + C) * 2u; voffB[i] = (unsigned)(Rb * K + C) * 2u; }
    const size_t kstep = (size_t)(BK * 2);
    const size_t hstep = (size_t)HALF * K * 2;
    const size_t tstep = 2 * hstep;
    const unsigned ldsw = (unsigned)wid * 1024u;
    const int aoff = lds_byte(wr * 64 + fr, fq * 8), boff = lds_byte(wc * 32 + fr, fq * 8);
#define PG8_SA(b, h) (((b) * 2 + (h)) * HTB)
#define PG8_SB(b, h) ((4 + (b) * 2 + (h)) * HTB)
#define PG8_STAGE(bufoff, gbase, voff) do { _Pragma("unroll") for (int _i = 0; _i < 2; ++_i) \
        __builtin_amdgcn_global_load_lds((const unsigned*)((const char*)(gbase) + (voff)[_i]), (PG8_LAS unsigned*)(lds + (bufoff) + ldsw + _i * 8192), 16, 0, 0); } while (0)
#define PG8_LDA(dst, b, h) do { _Pragma("unroll") for (int m = 0; m < 4; ++m) _Pragma("unroll") for (int k = 0; k < 2; ++k) dst[m][k] = *(const PG8_LAS bf16x8*)(lds + PG8_SA(b, h) + aoff + m * 2048 + k * 1024); } while (0)
#define PG8_LDB(dst, b, h) do { _Pragma("unroll") for (int n = 0; n < 2; ++n) _Pragma("unroll") for (int k = 0; k < 2; ++k) dst[n][k] = *(const PG8_LAS bf16x8*)(lds + PG8_SB(b, h) + boff + n * 2048 + k * 1024); } while (0)
#define PG8_MMA(ai, bj, At, Bt) do { __builtin_amdgcn_s_setprio(1); _Pragma("unroll") for (int m = 0; m < 4; ++m) _Pragma("unroll") for (int n = 0; n < 2; ++n) _Pragma("unroll") for (int k = 0; k < 2; ++k) \
        acc[ai][bj][m][n] = __builtin_amdgcn_mfma_f32_16x16x32_bf16(Bt[n][k], At[m][k], acc[ai][bj][m][n], 0, 0, 0); __builtin_amdgcn_s_setprio(0); } while (0)
#define PG8_WAIT_V(n) asm volatile("s_waitcnt vmcnt(" #n ")" ::: "memory")
#define PG8_WAIT_L(n) asm volatile("s_waitcnt lgkmcnt(" #n ")" ::: "memory")
#define PG8_BAR __builtin_amdgcn_s_barrier()
#define PG8_SCHED __builtin_amdgcn_sched_barrier(0)
    Unit cur, nxt; int ui = 0;
    if (!S.next(0, cur)) return;
    f32x4 acc[2][2][4][2];
#pragma unroll
    for (int a = 0; a < 2; ++a)
#pragma unroll
        for (int b = 0; b < 2; ++b)
#pragma unroll
            for (int m = 0; m < 4; ++m)
#pragma unroll
                for (int n = 0; n < 2; ++n) acc[a][b][m][n] = (f32x4){0.f, 0.f, 0.f, 0.f};
    bf16x8 At[4][2], B0[2][2], B1[2][2];
    const char* cA = (const char*)g.A + (size_t)cur.pm * tstep; const char* cB = (const char*)g.Bt + (size_t)cur.pn * tstep;
    S.a_ready(cur);
    if constexpr (SP2) {
        PG8_STAGE(PG8_SB(0, 0), cB, voffB); PG8_STAGE(PG8_SB(0, 1), cB + hstep, voffB); PG8_STAGE(PG8_SA(0, 0), cA, voffA); PG8_STAGE(PG8_SA(0, 1), cA + hstep, voffA);
        if (wr == 1) PG8_BAR;
        PG8_WAIT_V(2); PG8_BAR;
        PG8_STAGE(PG8_SB(1, 0), cB + kstep, voffB); PG8_STAGE(PG8_SA(1, 0), cA + kstep, voffA); PG8_STAGE(PG8_SB(1, 1), cB + hstep + kstep, voffB);
        PG8_WAIT_V(6); PG8_BAR;
    } else {
        PG8_STAGE(PG8_SB(0, 0), cB, voffB); PG8_STAGE(PG8_SA(0, 0), cA, voffA); PG8_STAGE(PG8_SB(0, 1), cB + hstep, voffB); PG8_STAGE(PG8_SA(0, 1), cA + hstep, voffA);
        if (wr == 1) PG8_BAR;
        PG8_WAIT_V(4); PG8_BAR;
        PG8_STAGE(PG8_SB(1, 0), cB + kstep, voffB); PG8_STAGE(PG8_SA(1, 0), cA + kstep, voffA); PG8_STAGE(PG8_SB(1, 1), cB + hstep + kstep, voffB);
        PG8_WAIT_V(6); PG8_BAR;
    }
    for (;;) {
        const bool has_next = S.next(ui + 1, nxt);
        const char* nA = has_next ? (const char*)g.A + (size_t)nxt.pm * tstep : cA; const char* nB = has_next ? (const char*)g.Bt + (size_t)nxt.pn * tstep : cB;
        for (int t = 0; t < nt; t += 2) {
            const bool last = (t == nt - 2);
            const char* a1 = cA + (size_t)(t + 1) * kstep;
            const char* a2 = last ? nA : cA + (size_t)(t + 2) * kstep; const char* b2 = last ? nB : cB + (size_t)(t + 2) * kstep;
            const char* a3 = a2 + kstep; const char* b3 = b2 + kstep;
            if (last && has_next) S.a_ready(nxt);
            if constexpr (SP2) {
            PG8_LDB(B0, 0, 0); PG8_LDB(B1, 0, 1); PG8_SCHED; PG8_LDA(At, 0, 0); PG8_STAGE(PG8_SA(1, 1), a1 + hstep, voffA);
            PG8_WAIT_V(8); PG8_WAIT_L(0); PG8_BAR; PG8_MMA(0, 0, At, B0); PG8_MMA(0, 1, At, B1); PG8_BAR; PG8_SCHED;
            PG8_LDA(At, 0, 1); PG8_STAGE(PG8_SB(0, 0), b2, voffB); PG8_STAGE(PG8_SB(0, 1), b2 + hstep, voffB); PG8_STAGE(PG8_SA(0, 0), a2, voffA);
            PG8_WAIT_V(8); PG8_WAIT_L(0); PG8_BAR; PG8_MMA(1, 0, At, B0); PG8_MMA(1, 1, At, B1); PG8_BAR; PG8_SCHED;
            PG8_LDB(B0, 1, 0); PG8_LDB(B1, 1, 1); PG8_SCHED; PG8_LDA(At, 1, 0); PG8_STAGE(PG8_SA(0, 1), a2 + hstep, voffA);
            PG8_WAIT_V(8); PG8_WAIT_L(0); PG8_BAR; PG8_MMA(0, 0, At, B0); PG8_MMA(0, 1, At, B1); PG8_BAR; PG8_SCHED;
            PG8_LDA(At, 1, 1); PG8_STAGE(PG8_SB(1, 0), b3, voffB); PG8_STAGE(PG8_SB(1, 1), b3 + hstep, voffB); PG8_STAGE(PG8_SA(1, 0), a3, voffA);
            PG8_WAIT_V(8); PG8_WAIT_L(0); PG8_BAR; PG8_MMA(1, 0, At, B0); PG8_MMA(1, 1, At, B1); PG8_BAR; PG8_SCHED;
            } else {
            PG8_LDB(B0, 0, 0); PG8_SCHED; PG8_LDA(At, 0, 0); PG8_STAGE(PG8_SA(1, 1), a1 + hstep, voffA);
            PG8_WAIT_L(8); PG8_BAR; PG8_WAIT_L(0); PG8_MMA(0, 0, At, B0); PG8_BAR; PG8_SCHED;
            PG8_LDB(B1, 0, 1); PG8_STAGE(PG8_SB(0, 0), b2, voffB);
            PG8_BAR; PG8_WAIT_L(0); PG8_MMA(0, 1, At, B1); PG8_BAR;
            PG8_LDA(At, 0, 1); PG8_STAGE(PG8_SA(0, 0), a2, voffA);
            PG8_BAR; PG8_WAIT_L(0); PG8_MMA(1, 0, At, B0); PG8_BAR; PG8_SCHED;
            PG8_STAGE(PG8_SB(0, 1), b2 + hstep, voffB);
            PG8_WAIT_V(6); PG8_BAR; PG8_MMA(1, 1, At, B1); PG8_BAR;
            PG8_LDB(B0, 1, 0); PG8_SCHED; PG8_LDA(At, 1, 0); PG8_STAGE(PG8_SA(0, 1), a2 + hstep, voffA);
            PG8_WAIT_L(8); PG8_BAR; PG8_WAIT_L(0); PG8_MMA(0, 0, At, B0); PG8_BAR; PG8_SCHED;
            PG8_LDB(B1, 1, 1); PG8_STAGE(PG8_SB(1, 0), b3, voffB);
            PG8_BAR; PG8_WAIT_L(0); PG8_MMA(0, 1, At, B1); PG8_BAR;
            PG8_LDA(At, 1, 1); PG8_STAGE(PG8_SA(1, 0), a3, voffA);
            PG8_BAR; PG8_WAIT_L(0); PG8_MMA(1, 0, At, B0); PG8_BAR; PG8_SCHED;
            PG8_STAGE(PG8_SB(1, 1), b3 + hstep, voffB);
            PG8_WAIT_V(6); PG8_BAR; PG8_MMA(1, 1, At, B1); PG8_BAR;
            }
        }
        if constexpr (ALIGN_EPI) { if (wr == 0) PG8_BAR; }
        if constexpr (!Epi::AFTER_DRAIN) { E(acc, cur, wr, wc, fr, fq); S.done(cur); }
        if (!has_next) break;
#pragma unroll
        for (int a = 0; a < 2; ++a)
#pragma unroll
            for (int b = 0; b < 2; ++b)
#pragma unroll
                for (int m = 0; m < 4; ++m)
#pragma unroll
                    for (int n = 0; n < 2; ++n) acc[a][b][m][n] = (f32x4){0.f, 0.f, 0.f, 0.f};
        cur = nxt; cA = nA; cB = nB; ++ui;
        if constexpr (ALIGN_EPI) { if (wr == 1) PG8_BAR; }
    }
    PG8_WAIT_V(0);
    if constexpr (!ALIGN_EPI) { if (wr == 0) PG8_BAR; }
    PG8_BAR;
    if constexpr (Epi::AFTER_DRAIN) { E.fused(acc, cur, wr, wc, fr, fq, lds, wid, lane); S.done(cur); }
#undef PG8_SA
#undef PG8_SB
#undef PG8_STAGE
#undef PG8_LDA
#undef PG8_LDB
#undef PG8_MMA
#undef PG8_WAIT_V
#undef PG8_WAIT_L
#undef PG8_BAR
#undef PG8_SCHED
}
}

namespace cg = cooperative_groups;
namespace mk {
using pg8::bf16_t; using pg8::bf16x8; using pg8::f32x4; using pg8::u32x4; using pg8::Unit; using pg8::Gemm;
typedef float f32x16 __attribute__((ext_vector_type(16)));
typedef float f32x2 __attribute__((ext_vector_type(2)));
typedef unsigned u32x2 __attribute__((ext_vector_type(2)));
typedef __bf16 bf16x2_t __attribute__((ext_vector_type(2)));

constexpr int D = 1024, NB = 8, S = 4096, M = NB * S, NT = 512;
constexpr float EPS = 1e-6f, LOG2E = 1.4426950408889634f, QSCALE = 0.125f * 1.4426950408889634f;
constexpr size_t MiB = 1ull << 20;
constexpr size_t WS_MOD = 0;
constexpr size_t WS_W0A = 256 * 1024;
constexpr size_t WS_WV  = WS_W0A + 10 * MiB;
constexpr size_t WS_WO0 = WS_WV + 2 * MiB;
constexpr size_t WS_WP  = WS_WO0 + 4 * MiB;
constexpr size_t WS_W1  = WS_WP + MiB / 2;
constexpr size_t WS_WO1 = WS_W1 + 16 * MiB;
constexpr size_t WS_H   = WS_WO1 + 4 * MiB;
constexpr size_t WS_BIG = WS_H + 64 * MiB;
constexpr size_t WS_U = WS_BIG, WS_Q = WS_BIG + 64 * MiB, WS_K = WS_BIG + 128 * MiB, WS_VT = WS_BIG + 192 * MiB, WS_G = WS_BIG + 256 * MiB;
constexpr size_t WS_UP = WS_BIG, WS_G1 = WS_BIG + 128 * MiB;
constexpr size_t WS_END = WS_BIG + 384 * MiB;

struct Args { const float* in[14]; float* out; unsigned char* ws; int ph_lo, ph_hi; };

#define MK_DI __device__ __forceinline__
MK_DI unsigned pk(float lo, float hi) { f32x2 v = {lo, hi}; return __builtin_bit_cast(unsigned, __builtin_convertvector(v, bf16x2_t)); }
MK_DI float bflo(unsigned w) { return __uint_as_float(w << 16); }
MK_DI float bfhi(unsigned w) { return __uint_as_float(w & 0xffff0000u); }
MK_DI float silu_f(float v) { return v * __builtin_amdgcn_rcpf(1.0f + __builtin_amdgcn_exp2f(-v * LOG2E)); }
MK_DI void unpack8(const u32x4 w, float (&f)[8]) { f[0] = bflo(w.x); f[1] = bfhi(w.x); f[2] = bflo(w.y); f[3] = bfhi(w.y); f[4] = bflo(w.z); f[5] = bfhi(w.z); f[6] = bflo(w.w); f[7] = bfhi(w.w); }
MK_DI u32x4 pack8(const float (&f)[8]) { u32x4 w; w.x = pk(f[0], f[1]); w.y = pk(f[2], f[3]); w.z = pk(f[4], f[5]); w.w = pk(f[6], f[7]); return w; }

MK_DI void p0_adaln(const float* c, const float* ada_w, const float* ada_b, float* mod, float* sm) {
    const int tid = threadIdx.x;
    for (int blk = blockIdx.x; blk < 192; blk += gridDim.x) {
        for (int i = tid; i < 8192; i += NT) sm[i] = silu_f(c[i]);
        __syncthreads();
        const int col = tid & 31, ks = tid >> 5;
        const int gcn = blk * 32 + col, l = gcn / 3072, n = gcn % 3072;
        float acc[8];
#pragma unroll
        for (int b = 0; b < 8; ++b) acc[b] = 0.f;
        const float* w = ada_w + (size_t)l * 1024 * 3072 + n;
        for (int kk = 0; kk < 64; ++kk) {
            const int k = ks + 16 * kk; const float wv = w[(size_t)k * 3072];
#pragma unroll
            for (int b = 0; b < 8; ++b) acc[b] += sm[b * 1024 + k] * wv;
        }
        float* red = sm + 8192;
#pragma unroll
        for (int b = 0; b < 8; ++b) red[(ks * 32 + col) * 8 + b] = acc[b];
        __syncthreads();
        if (tid < 256) {
            const int cc = tid & 31, b = tid >> 5; float s = 0.f;
            for (int k2 = 0; k2 < 16; ++k2) s += red[(k2 * 32 + cc) * 8 + b];
            const int g2 = blk * 32 + cc, l2 = g2 / 3072, n2 = g2 % 3072;
            mod[(l2 * 8 + b) * 3072 + n2] = s + ada_b[l2 * 3072 + n2];
        }
        __syncthreads();
    }
}

MK_DI void p0_transpose(const Args& a, float* sm) {
    const int tid = threadIdx.x;
    unsigned char* ws = a.ws;
    for (int t = blockIdx.x; t < 4672; t += gridDim.x) {
        const float* src; bf16_t* dst; int ld, K, tn, tk, mode;
        if (t < 1280)      { src = a.in[5];  ld = 6144; K = 1024; tn = t >> 4; tk = t & 15; mode = 0; dst = (bf16_t*)(ws + WS_W0A); }
        else if (t < 1536) { const int u = t - 1280; src = a.in[5] + 3072; ld = 6144; K = 1024; tn = u >> 4; tk = u & 15; mode = 1; dst = (bf16_t*)(ws + WS_WV); }
        else if (t < 2048) { const int u = t - 1536; src = a.in[8];  ld = 1024; K = 2048; tn = u >> 5; tk = u & 31; mode = 1; dst = (bf16_t*)(ws + WS_WO0); }
        else if (t < 2112) { const int u = t - 2048, g = u >> 4, r = u & 15; src = a.in[6] + g * 65536; ld = 256; K = 256; tn = r >> 2; tk = r & 3; mode = 1; dst = (bf16_t*)(ws + WS_WP) + g * 65536; }
        else if (t < 4160) { const int u = t - 2112; src = a.in[9];  ld = 8192; K = 1024; tn = u >> 4; tk = u & 15; mode = 2; dst = (bf16_t*)(ws + WS_W1); }
        else               { const int u = t - 4160; src = a.in[12]; ld = 1024; K = 2048; tn = u >> 5; tk = u & 31; mode = 1; dst = (bf16_t*)(ws + WS_WO1); }
        const int nn = tid & 63, n1 = tn * 64 + nn, kr = tid >> 6;
        int col;
        if (mode == 0) col = n1 < 3072 ? n1 : n1 + 1024;
        else if (mode == 1) col = n1;
        else { const int pn = n1 >> 8, bj = (n1 >> 7) & 1, wc = (n1 >> 5) & 3, n = (n1 >> 4) & 1, fq = (n1 >> 2) & 3, j = n1 & 3; col = (2 * bj + n) * 2048 + 64 * pn + 16 * wc + 4 * fq + j; }
        const float* sp = src + (size_t)(tk * 64 + kr) * ld + col;
#pragma unroll
        for (int e = 0; e < 8; ++e) sm[nn * 65 + kr + 8 * e] = sp[(size_t)(8 * e) * ld];
        __syncthreads();
        const int wn = tid >> 3, kc = (tid & 7) * 8;
        float f[8];
#pragma unroll
        for (int i = 0; i < 8; ++i) f[i] = sm[wn * 65 + kc + i];
        *(u32x4*)(dst + (size_t)(tn * 64 + wn) * K + tk * 64 + kc) = pack8(f);
        __syncthreads();
    }
}

MK_DI float wave_sum(float v) {
#pragma unroll
    for (int off = 32; off >= 1; off >>= 1) v += __shfl_xor(v, off);
    return v;
}
MK_DI void p_norm_mod(const float* xin, const float* g, const float* modl, bf16_t* H) {
    const int tid = threadIdx.x, lane = tid & 63, wid = tid >> 6;
    for (int row = blockIdx.x * 8 + wid; row < M; row += gridDim.x * 8) {
        const float* xr = xin + (size_t)row * D + 4 * lane;
        f32x4 v[4];
#pragma unroll
        for (int j = 0; j < 4; ++j) v[j] = *(const f32x4*)(xr + 256 * j);
        float ss = 0.f;
#pragma unroll
        for (int j = 0; j < 4; ++j) ss += v[j].x * v[j].x + v[j].y * v[j].y + v[j].z * v[j].z + v[j].w * v[j].w;
        ss = wave_sum(ss);
        const float rstd = rsqrtf(ss * (1.0f / 1024.0f) + EPS);
        const float* mb = modl + (row >> 12) * 3072 + 4 * lane;
#pragma unroll
        for (int j = 0; j < 4; ++j) {
            const f32x4 gv = *(const f32x4*)(g + 4 * lane + 256 * j), sh = *(const f32x4*)(mb + 256 * j), sc = *(const f32x4*)(mb + 1024 + 256 * j);
            const f32x4 hh = (v[j] * rstd) * gv * (sc + 1.0f) + sh;
            u32x2 w; w.x = pk(hh.x, hh.y); w.y = pk(hh.z, hh.w);
            *(u32x2*)(H + (size_t)row * D + 4 * lane + 256 * j) = w;
        }
    }
}
MK_DI void p_final_norm(float* xo, const float* g) {
    const int tid = threadIdx.x, lane = tid & 63, wid = tid >> 6;
    for (int row = blockIdx.x * 8 + wid; row < M; row += gridDim.x * 8) {
        float* xr = xo + (size_t)row * D + 4 * lane;
        f32x4 v[4];
#pragma unroll
        for (int j = 0; j < 4; ++j) v[j] = *(const f32x4*)(xr + 256 * j);
        float ss = 0.f;
#pragma unroll
        for (int j = 0; j < 4; ++j) ss += v[j].x * v[j].x + v[j].y * v[j].y + v[j].z * v[j].z + v[j].w * v[j].w;
        ss = wave_sum(ss);
        const float rstd = rsqrtf(ss * (1.0f / 1024.0f) + EPS);
#pragma unroll
        for (int j = 0; j < 4; ++j) { const f32x4 gv = *(const f32x4*)(g + 4 * lane + 256 * j); *(f32x4*)(xr + 256 * j) = (v[j] * rstd) * gv; }
    }
}

struct EpiProj0 {
    static constexpr bool PERM = true, AFTER_DRAIN = false;
    bf16_t *U, *Q, *Kh, *G;
    MK_DI void operator()(const f32x4 (&acc)[2][2][4][2], const Unit& u, int wr, int wc, int fr, int fq) const {
        const int reg = u.pn >> 2, row0 = u.pm * 256 + wr * 64 + fr, cb = u.pn * 256 + wc * 32 + 8 * fq;
#pragma unroll
        for (int ai = 0; ai < 2; ++ai)
#pragma unroll
            for (int m = 0; m < 4; ++m) {
                const int row = row0 + ai * 128 + m * 16;
#pragma unroll
                for (int bj = 0; bj < 2; ++bj) {
                    const int c = cb + bj * 128; f32x4 v0 = acc[ai][bj][m][0], v1 = acc[ai][bj][m][1]; bf16_t* ptr;
                    if (reg == 0) ptr = U + (size_t)row * 1024 + c;
                    else if (reg == 1) { v0 *= QSCALE; v1 *= QSCALE; ptr = Q + (size_t)row * 1024 + (c - 1024); }
                    else if (reg == 2) { const int cc = c - 2048; ptr = Kh + ((size_t)((row >> 12) * 16 + (cc >> 6)) * 4096 + (row & 4095)) * 64 + (cc & 63); }
                    else { v0.x = silu_f(v0.x); v0.y = silu_f(v0.y); v0.z = silu_f(v0.z); v0.w = silu_f(v0.w); v1.x = silu_f(v1.x); v1.y = silu_f(v1.y); v1.z = silu_f(v1.z); v1.w = silu_f(v1.w);
                           ptr = G + (size_t)row * 2048 + (c - 3072); }
                    u32x4 w; w.x = pk(v0.x, v0.y); w.y = pk(v0.z, v0.w); w.z = pk(v1.x, v1.y); w.w = pk(v1.z, v1.w);
                    *(u32x4*)ptr = w;
                }
            }
    }
};
struct EpiVt {
    static constexpr bool PERM = true, AFTER_DRAIN = false;
    bf16_t* Vt;
    MK_DI void operator()(const f32x4 (&acc)[2][2][4][2], const Unit& u, int wr, int wc, int fr, int fq) const {
        const int row0 = u.pm * 256 + wr * 64 + fr, cb = u.pn * 256 + wc * 32 + 8 * fq;
#pragma unroll
        for (int ai = 0; ai < 2; ++ai)
#pragma unroll
            for (int m = 0; m < 4; ++m) {
                const int row = row0 + ai * 128 + m * 16;
#pragma unroll
                for (int bj = 0; bj < 2; ++bj) {
                    const f32x4 v0 = acc[ai][bj][m][0], v1 = acc[ai][bj][m][1];
                    u32x4 w; w.x = pk(v0.x, v0.y); w.y = pk(v0.z, v0.w); w.z = pk(v1.x, v1.y); w.w = pk(v1.z, v1.w);
                    *(u32x4*)(Vt + (size_t)row * 32768 + cb + bj * 128) = w;
                }
            }
    }
};
struct EpiRes {
    static constexpr bool PERM = false, AFTER_DRAIN = false;
    const float* res; float* out; const float* gate;
    MK_DI void operator()(const f32x4 (&acc)[2][2][4][2], const Unit& u, int wr, int wc, int fr, int fq) const {
        const int row0 = u.pm * 256 + wr * 64 + fr, col0 = u.pn * 256 + wc * 32 + 4 * fq, b = (u.pm * 256) >> 12;
        f32x4 gv[2][2];
#pragma unroll
        for (int bj = 0; bj < 2; ++bj)
#pragma unroll
            for (int n = 0; n < 2; ++n) gv[bj][n] = *(const f32x4*)(gate + b * 3072 + col0 + bj * 128 + n * 16) + 1.0f;
#pragma unroll
        for (int ai = 0; ai < 2; ++ai)
#pragma unroll
            for (int m = 0; m < 4; ++m) {
                const size_t off = (size_t)(row0 + ai * 128 + m * 16) * 1024 + col0;
#pragma unroll
                for (int bj = 0; bj < 2; ++bj)
#pragma unroll
                    for (int n = 0; n < 2; ++n) { const size_t o = off + bj * 128 + n * 16; const f32x4 r = *(const f32x4*)(res + o); *(f32x4*)(out + o) = r + gv[bj][n] * acc[ai][bj][m][n]; }
            }
    }
};
struct EpiGate {
    static constexpr bool PERM = false, AFTER_DRAIN = false;
    bf16_t *UP, *G1;
    MK_DI void operator()(const f32x4 (&acc)[2][2][4][2], const Unit& u, int wr, int wc, int fr, int fq) const {
        const int row0 = u.pm * 256 + wr * 64 + fr, ch0 = u.pn * 64 + wc * 16 + 4 * fq;
#pragma unroll
        for (int ai = 0; ai < 2; ++ai)
#pragma unroll
            for (int m = 0; m < 4; ++m) {
                const size_t off = (size_t)(row0 + ai * 128 + m * 16) * 2048 + ch0;
                const f32x4 gb = acc[ai][0][m][0], gc = acc[ai][0][m][1], uu = acc[ai][1][m][0], gt = acc[ai][1][m][1];
                const f32x4 up = gc * uu;
                f32x4 gg; gg.x = gb.x * silu_f(gt.x); gg.y = gb.y * silu_f(gt.y); gg.z = gb.z * silu_f(gt.z); gg.w = gb.w * silu_f(gt.w);
                u32x2 w0, w1; w0.x = pk(up.x, up.y); w0.y = pk(up.z, up.w); w1.x = pk(gg.x, gg.y); w1.y = pk(gg.z, gg.w);
                *(u32x2*)(UP + off) = w0; *(u32x2*)(G1 + off) = w1;
            }
    }
};
struct EpiPool {
    static constexpr bool PERM = true, AFTER_DRAIN = false;
    bf16_t* G; const float* pscale;
    MK_DI void operator()(const f32x4 (&acc)[2][2][4][2], const Unit& u, int wr, int wc, int fr, int fq) const {
        const int row0 = (u.pm & 127) * 256 + wr * 64 + fr, cb = u.pn * 256 + wc * 32 + 8 * fq;
        f32x4 ps[2][2];
#pragma unroll
        for (int bj = 0; bj < 2; ++bj) { ps[bj][0] = *(const f32x4*)(pscale + cb + bj * 128); ps[bj][1] = *(const f32x4*)(pscale + cb + bj * 128 + 4); }
#pragma unroll
        for (int ai = 0; ai < 2; ++ai)
#pragma unroll
            for (int m = 0; m < 4; ++m) {
                const int row = row0 + ai * 128 + m * 16;
#pragma unroll
                for (int bj = 0; bj < 2; ++bj) {
                    bf16_t* ptr = G + (size_t)row * 2048 + cb + bj * 128;
                    const u32x4 gw = *(const u32x4*)ptr;
                    const f32x4 v0 = acc[ai][bj][m][0] * ps[bj][0], v1 = acc[ai][bj][m][1] * ps[bj][1];
                    u32x4 w; w.x = pk(v0.x * bflo(gw.x), v0.y * bfhi(gw.x)); w.y = pk(v0.z * bflo(gw.y), v0.w * bfhi(gw.y));
                    w.z = pk(v1.x * bflo(gw.z), v1.y * bfhi(gw.z)); w.w = pk(v1.z * bflo(gw.w), v1.w * bfhi(gw.w));
                    *(u32x4*)ptr = w;
                }
            }
    }
};
struct PoolSched {
    int G, c;
    __device__ bool next(int i, Unit& u) const { const int L = i * G + c; if (L >= 512) return false; u.pm = L; u.pn = L >> 7; return true; }
    MK_DI void a_ready(const Unit&) const {}
    MK_DI void done(const Unit&) const {}
};

MK_DI void p_pool_prep(const bf16_t* U, bf16_t* P) {
    for (int item = blockIdx.x * NT + threadIdx.x; item < 1024 * 128; item += gridDim.x * NT) {
        const int chunk = item & 127, tb = item >> 7, g = chunk >> 5, w = 2 << g, t0 = tb * 32, pos0 = t0 & 4095;
        const bf16_t* up = U + (size_t)t0 * 1024 + chunk * 8;
        bf16_t* pp = P + ((size_t)g * 32768 + t0) * 256 + (chunk & 31) * 8;
        float s[8];
#pragma unroll
        for (int i = 0; i < 8; ++i) s[i] = 0.f;
        for (int i = 1; i < w; ++i) if (pos0 - i >= 0) { float f[8]; unpack8(*(const u32x4*)(up - (ptrdiff_t)i * 1024), f);
#pragma unroll
            for (int e = 0; e < 8; ++e) s[e] += f[e]; }
        for (int tt = 0; tt < 32; ++tt) {
            float cur[8], p[8]; unpack8(*(const u32x4*)(up + (size_t)tt * 1024), cur);
            const int cnt = (pos0 + tt + 1) < w ? (pos0 + tt + 1) : w; const float inv = 1.0f / (float)cnt;
#pragma unroll
            for (int e = 0; e < 8; ++e) { s[e] += cur[e]; p[e] = s[e] * inv - cur[e]; }
            *(u32x4*)(pp + (size_t)tt * 256) = pack8(p);
            const int old = tt - (w - 1);
            if (pos0 + old >= 0) { float f[8]; unpack8(*(const u32x4*)(up + (ptrdiff_t)old * 1024), f);
#pragma unroll
                for (int e = 0; e < 8; ++e) s[e] -= f[e]; }
        }
    }
}

#define MK_MFMA32(a, b, c) __builtin_amdgcn_mfma_f32_32x32x16_bf16((a), (b), (c), 0, 0, 0)
MK_DI void p_attn(const bf16_t* Q, const bf16_t* Kh, const bf16_t* Vt, bf16_t* G) {
    const int tid = threadIdx.x, lane = tid & 63, wid = tid >> 6, r = lane & 31, h = lane >> 5;
    const int pr = (r & 0x13) | ((r & 4) << 1) | ((r & 8) >> 1);
    for (int unit = blockIdx.x * 8 + wid; unit < 16384; unit += gridDim.x * 8) {
        const int qb = unit & 127, head = (unit >> 7) & 15, b = unit >> 11, q0 = qb * 32;
        const bf16_t* qp = Q + (size_t)(b * 4096 + q0 + r) * 1024 + head * 64 + 8 * h;
        bf16x8 qf[4];
#pragma unroll
        for (int kk = 0; kk < 4; ++kk) qf[kk] = *(const bf16x8*)(qp + 16 * kk);
        const bf16_t* kbase = Kh + ((size_t)(b * 16 + head) * 4096 + pr) * 64 + 8 * h;
        const bf16_t* vbase = Vt + (size_t)(head * 64 + r) * 32768 + b * 4096 + 8 * h;
        f32x16 o0, o1;
#pragma unroll
        for (int i = 0; i < 16; ++i) { o0[i] = 0.f; o1[i] = 0.f; }
        float carry = 1.0f;
        bf16x8 kf[4], vf[4];
#pragma unroll
        for (int kk = 0; kk < 4; ++kk) kf[kk] = *(const bf16x8*)(kbase + (size_t)q0 * 64 + 16 * kk);
#pragma unroll
        for (int i = 0; i < 4; ++i) vf[i] = *(const bf16x8*)(vbase + (size_t)(i >> 1) * 32 * 32768 + q0 + 16 * (i & 1));
        int k0 = q0;
        for (;;) {
            const int k1 = k0 - 32, kl = k1 < 0 ? 0 : k1;
            bf16x8 kn[4], vn[4];
#pragma unroll
            for (int kk = 0; kk < 4; ++kk) kn[kk] = *(const bf16x8*)(kbase + (size_t)kl * 64 + 16 * kk);
#pragma unroll
            for (int i = 0; i < 4; ++i) vn[i] = *(const bf16x8*)(vbase + (size_t)(i >> 1) * 32 * 32768 + kl + 16 * (i & 1));
            f32x16 z;
#pragma unroll
            for (int i = 0; i < 16; ++i) z[i] = 0.f;
#pragma unroll
            for (int kk = 0; kk < 4; ++kk) z = MK_MFMA32(kf[kk], qf[kk], z);
            const bool diag = (k0 == q0);
            float ez[16], cf[16];
#pragma unroll
            for (int i = 0; i < 16; ++i) {
                const int krel = 16 * (i >> 3) + 8 * h + (i & 7);
                float zz = fminf(z[i], 100.0f);
                if (diag && krel >= r) zz = -__builtin_inff();
                ez[i] = __builtin_amdgcn_exp2f(zz);
                cf[i] = __builtin_amdgcn_rcpf(1.0f + ez[i]);
            }
#pragma unroll
            for (int i = 6; i >= 0; --i) { cf[i] *= cf[i + 1]; cf[i + 8] *= cf[i + 9]; }
            const float plo = cf[0], phi = cf[8];
            const float plo_p = __shfl_xor(plo, 32), phi_p = __shfl_xor(phi, 32);
            const float pre_hi = carry * (h == 0 ? phi_p : 1.0f);
            const float pre_lo = carry * (phi * phi_p) * (h == 0 ? plo_p : 1.0f);
            carry = carry * (plo * plo_p) * (phi * phi_p);
            float a[16];
#pragma unroll
            for (int i = 0; i < 8; ++i) { a[i] = (ez[i] * cf[i]) * pre_lo; a[i + 8] = (ez[i + 8] * cf[i + 8]) * pre_hi; }
            u32x4 w0, w1;
            w0.x = pk(a[0], a[1]); w0.y = pk(a[2], a[3]); w0.z = pk(a[4], a[5]); w0.w = pk(a[6], a[7]);
            w1.x = pk(a[8], a[9]); w1.y = pk(a[10], a[11]); w1.z = pk(a[12], a[13]); w1.w = pk(a[14], a[15]);
            const bf16x8 p0 = __builtin_bit_cast(bf16x8, w0), p1 = __builtin_bit_cast(bf16x8, w1);
            o0 = MK_MFMA32(vf[0], p0, o0); o0 = MK_MFMA32(vf[1], p1, o0);
            o1 = MK_MFMA32(vf[2], p0, o1); o1 = MK_MFMA32(vf[3], p1, o1);
            if (k1 < 0) break;
            if (__all(carry < 1e-37f)) break;
#pragma unroll
            for (int i = 0; i < 4; ++i) { kf[i] = kn[i]; vf[i] = vn[i]; }
            k0 = k1;
        }
        bf16_t* gp = G + (size_t)(b * 4096 + q0 + r) * 2048 + 1024 + head * 64 + 4 * h;
#pragma unroll
        for (int g4 = 0; g4 < 4; ++g4) {
            { u32x2* p = (u32x2*)(gp + 8 * g4); const u32x2 gw = *p; u32x2 w;
              w.x = pk(o0[4 * g4] * bflo(gw.x), o0[4 * g4 + 1] * bfhi(gw.x)); w.y = pk(o0[4 * g4 + 2] * bflo(gw.y), o0[4 * g4 + 3] * bfhi(gw.y)); *p = w; }
            { u32x2* p = (u32x2*)(gp + 32 + 8 * g4); const u32x2 gw = *p; u32x2 w;
              w.x = pk(o1[4 * g4] * bflo(gw.x), o1[4 * g4 + 1] * bfhi(gw.x)); w.y = pk(o1[4 * g4 + 2] * bflo(gw.y), o1[4 * g4 + 3] * bfhi(gw.y)); *p = w; }
        }
    }
}

MK_DI void p_conv(const bf16_t* UP, bf16_t* G1, const float* cw, const float* cbias) {
    for (int item = blockIdx.x * NT + threadIdx.x; item < 2048 * 256; item += gridDim.x * NT) {
        const int chunk = item & 255, tb = item >> 8, t0 = tb * 16, pos0 = t0 & 4095, c0 = chunk * 8;
        float w0[8], w1[8], w2[8], bb[8], um2[8], um1[8];
#pragma unroll
        for (int e = 0; e < 8; ++e) { w0[e] = cw[c0 + e]; w1[e] = cw[2048 + c0 + e]; w2[e] = cw[4096 + c0 + e]; bb[e] = cbias[c0 + e]; um2[e] = 0.f; um1[e] = 0.f; }
        const bf16_t* up = UP + (size_t)t0 * 2048 + c0; bf16_t* gp = G1 + (size_t)t0 * 2048 + c0;
        if (pos0 != 0) { unpack8(*(const u32x4*)(up - 4096), um2); unpack8(*(const u32x4*)(up - 2048), um1); }
        for (int tt = 0; tt < 16; ++tt) {
            float cur[8], gg[8], y[8];
            unpack8(*(const u32x4*)(up + (size_t)tt * 2048), cur); unpack8(*(const u32x4*)(gp + (size_t)tt * 2048), gg);
#pragma unroll
            for (int e = 0; e < 8; ++e) { y[e] = gg[e] * (bb[e] + w0[e] * um2[e] + w1[e] * um1[e] + w2[e] * cur[e]); um2[e] = um1[e]; um1[e] = cur[e]; }
            *(u32x4*)(gp + (size_t)tt * 2048) = pack8(y);
        }
    }
}

template <class Epi> MK_DI void run_gemm(PG8_LAS unsigned char* lds, const bf16_t* A, const bf16_t* Bt, int Mr, int Nc, int K, const Epi& E) {
    Gemm g; g.A = A; g.Bt = Bt; g.M = Mr; g.N = Nc; g.K = K;
    pg8::StaticOrder so; so.init(Mr, Nc, (int)gridDim.x, (int)blockIdx.x);
    pg8::gemm_phase<Epi, pg8::StaticOrder, true, true>(lds, g, so, E);
}

__global__ void __launch_bounds__(512, 2) mk_fwd(Args a) {
    extern __shared__ __attribute__((aligned(16))) unsigned char smem[];
    cg::grid_group grid = cg::this_grid();
    PG8_LAS unsigned char* lds = (PG8_LAS unsigned char*)smem;
    float* smf = (float*)smem;
    unsigned char* ws = a.ws;
    const int lo = a.ph_lo, hi = a.ph_hi;
    float* mod = (float*)(ws + WS_MOD);
    bf16_t* H = (bf16_t*)(ws + WS_H);
    bf16_t *U = (bf16_t*)(ws + WS_U), *Q = (bf16_t*)(ws + WS_Q), *Kh = (bf16_t*)(ws + WS_K), *Vt = (bf16_t*)(ws + WS_VT), *G = (bf16_t*)(ws + WS_G);
    bf16_t *UP = (bf16_t*)(ws + WS_UP), *G1 = (bf16_t*)(ws + WS_G1);
#define MK_IN(k) (lo <= (k) && (k) < hi)
#define MK_SEAM(k) do { if (MK_IN(k) && MK_IN((k) + 1)) grid.sync(); } while (0)
    if (MK_IN(0)) { p0_adaln(a.in[1], a.in[3], a.in[4], mod, smf); p0_transpose(a, smf); }
    MK_SEAM(0);
    if (MK_IN(1)) p_norm_mod(a.in[0], a.in[2], mod, H);
    MK_SEAM(1);
    if (MK_IN(2)) {
        EpiProj0 e0; e0.U = U; e0.Q = Q; e0.Kh = Kh; e0.G = G;
        run_gemm(lds, H, (const bf16_t*)(ws + WS_W0A), M, 5120, 1024, e0);
        EpiVt e1; e1.Vt = Vt;
        run_gemm(lds, (const bf16_t*)(ws + WS_WV), H, 1024, M, 1024, e1);
    }
    MK_SEAM(2);
    if (MK_IN(3)) { p_attn(Q, Kh, Vt, G); p_pool_prep(U, H); }
    MK_SEAM(3);
    if (MK_IN(4)) {
        EpiPool e; e.G = G; e.pscale = a.in[7];
        Gemm g; g.A = H; g.Bt = (const bf16_t*)(ws + WS_WP); g.M = 4 * M; g.N = 1024; g.K = 256;
        PoolSched ps; ps.G = (int)gridDim.x; ps.c = (int)blockIdx.x;
        pg8::gemm_phase<EpiPool, PoolSched, true, true>(lds, g, ps, e);
    }
    MK_SEAM(4);
    if (MK_IN(5)) { EpiRes e; e.res = a.in[0]; e.out = a.out; e.gate = mod + 2048; run_gemm(lds, G, (const bf16_t*)(ws + WS_WO0), M, 1024, 2048, e); }
    MK_SEAM(5);
    if (MK_IN(6)) p_norm_mod(a.out, a.in[2] + 1024, mod + 8 * 3072, H);
    MK_SEAM(6);
    if (MK_IN(7)) { EpiGate e; e.UP = UP; e.G1 = G1; run_gemm(lds, H, (const bf16_t*)(ws + WS_W1), M, 8192, 1024, e); }
    MK_SEAM(7);
    if (MK_IN(8)) p_conv(UP, G1, a.in[10], a.in[11]);
    MK_SEAM(8);
    if (MK_IN(9)) { EpiRes e; e.res = a.out; e.out = a.out; e.gate = mod + 8 * 3072 + 2048; run_gemm(lds, G1, (const bf16_t*)(ws + WS_WO1), M, 1024, 2048, e); }
    MK_SEAM(9);
    if (MK_IN(10)) p_final_norm(a.out, a.in[13]);
}
}

#ifndef MK_ONE_LAUNCH
#define MK_ONE_LAUNCH 1
#endif
constexpr int MK_LDS_BYTES = 131072;
extern "C" void kernel_launch(void* const* d_in, const int* in_sizes, int n_in, void* d_out, int out_size, void* d_ws, size_t ws_size, hipStream_t stream) {
    static int grid = 0;
    if (grid == 0) {
        if (n_in != 14 || out_size != mk::M * mk::D || ws_size < mk::WS_END) { fprintf(stderr, "kernel_launch: unexpected shapes (n_in %d, out %d, ws %zu < %zu)\n", n_in, out_size, ws_size, (size_t)mk::WS_END); grid = -1; return; }
        int dev = 0, cus = 0, per_cu = 0;
        if (hipGetDevice(&dev) != hipSuccess || hipDeviceGetAttribute(&cus, hipDeviceAttributeMultiprocessorCount, dev) != hipSuccess) { grid = -1; return; }
        if (hipFuncSetAttribute((const void*)mk::mk_fwd, hipFuncAttributeMaxDynamicSharedMemorySize, MK_LDS_BYTES) != hipSuccess) { fprintf(stderr, "kernel_launch: hipFuncSetAttribute failed\n"); grid = -1; return; }
        if (hipOccupancyMaxActiveBlocksPerMultiprocessor(&per_cu, (const void*)mk::mk_fwd, 512, MK_LDS_BYTES) != hipSuccess || per_cu < 1) { per_cu = 1; (void)hipGetLastError(); }
        grid = cus;
    }
    if (grid < 0) return;
    mk::Args a{};
    for (int i = 0; i < 14; ++i) a.in[i] = (const float*)d_in[i];
    a.out = (float*)d_out; a.ws = (unsigned char*)d_ws;
#if MK_ONE_LAUNCH
    a.ph_lo = 0; a.ph_hi = 11;
    void* args[] = {&a};
    hipError_t e = hipLaunchCooperativeKernel((const void*)mk::mk_fwd, dim3(grid), dim3(512), args, MK_LDS_BYTES, stream);
    if (e != hipSuccess) fprintf(stderr, "kernel_launch: cooperative launch failed: %s (grid %d)\n", hipGetErrorString(e), grid);
#else
    for (int ph = 0; ph < 11; ++ph) { a.ph_lo = ph; a.ph_hi = ph + 1; hipLaunchKernelGGL(mk::mk_fwd, dim3(grid), dim3(512), MK_LDS_BYTES, stream, a); }
#endif
}
```

```cpp
#include <hip/hip_runtime.h>
#include <hip/hip_cooperative_groups.h>
#include <cstdio>
#include <cstdint>
namespace pg8 {
#define PG8_LAS __attribute__((address_space(3)))
typedef unsigned short bf16_t;
typedef short bf16x8 __attribute__((ext_vector_type(8)));
typedef float f32x4 __attribute__((ext_vector_type(4)));
typedef unsigned u32x4 __attribute__((ext_vector_type(4)));
constexpr int BM = 256, BK = 64, HALF = 128, HTB = HALF * BK * 2  , STAGE_BYTES = 8 * HTB, NXCD = 8, WGM = 8;

__host__ __device__ __forceinline__ int lds_byte(int r, int c) { const int st = (r >> 4) * 2 + (c >> 5), rr = r & 15, cc = c & 31, ob = rr * 64 + cc * 2; return st * 1024 + (ob ^ (((ob >> 9) & 1) << 5)); }
__host__ __device__ __forceinline__ void stage_rc(int b, int& R, int& C) { const int st = b / 1024, sb = b % 1024, swz = sb ^ (((sb >> 9) & 1) << 5); R = (st >> 1) * 16 + swz / 64; C = (st & 1) * 32 + (swz % 64) / 2; }
__host__ __device__ __forceinline__ int perm32(int rho) { const int n = rho >> 4, i = rho & 15; return 8 * (i >> 2) + 4 * n + (i & 3); }

struct Unit { int pm, pn; };
struct Gemm { const bf16_t* A; const bf16_t* Bt; int M, N, K; };

struct StaticOrder {
    int nM, nN, nwg, G, c;
    __host__ __device__ void init(int M, int N, int G_, int c_) { nM = M / BM; nN = N / BM; nwg = nM * nN; G = G_; c = c_; }
    __host__ __device__ bool next(int i, Unit& u) const {
        const long L = (long)i * G + c; if (L >= nwg) return false;
        int wgid = (int)L; { const int q = nwg / NXCD, r = nwg % NXCD, xcd = wgid % NXCD, off = wgid / NXCD; wgid = (xcd < r ? xcd * (q + 1) : r * (q + 1) + (xcd - r) * q) + off; }
        const int nig = WGM * nN, gid = wgid / nig, fm = gid * WGM, gsz = (nM - fm) < WGM ? (nM - fm) : WGM;
        u.pm = fm + ((wgid % nig) % gsz); u.pn = (wgid % nig) / gsz; return true;
    }
    __device__ __forceinline__ void a_ready(const Unit&) const {}
    __device__ __forceinline__ void done(const Unit&) const {}
};
__device__ __forceinline__ unsigned cvt_pk_bf16(float lo, float hi) { unsigned r; asm volatile("v_cvt_pk_bf16_f32 %0, %1, %2" : "=v"(r) : "v"(lo), "v"(hi)); return r; }
template <class Epi, class Sched, bool ALIGN_EPI = false, bool SP2 = false>
__device__ __forceinline__ void gemm_phase(PG8_LAS unsigned char* lds, const Gemm g, const Sched& S, const Epi& E) {
    const int tid = threadIdx.x, wid = __builtin_amdgcn_readfirstlane(tid >> 6), lane = tid & 63, wr = wid >> 2, wc = wid & 3, fr = lane & 15, fq = lane >> 4;
    const int K = g.K, nt = K / BK;
    unsigned voffA[2], voffB[2];
#pragma unroll
    for (int i = 0; i < 2; ++i) { int R, C; stage_rc(tid * 16 + i * 8192, R, C); const int Rb = Epi::PERM ? ((R & ~31) + perm32(R & 31)) : R;
        voffA[i] = (unsigned)(R * K + C) * 2u; voffB[i] = (unsigned)(Rb * K + C) * 2u; }
    const size_t kstep = (size_t)(BK * 2);
    const size_t hstep = (size_t)HALF * K * 2;
    const size_t tstep = 2 * hstep;
    const unsigned ldsw = (unsigned)wid * 1024u;
    const int aoff = lds_byte(wr * 64 + fr, fq * 8), boff = lds_byte(wc * 32 + fr, fq * 8);
#define PG8_SA(b, h) (((b) * 2 + (h)) * HTB)
#define PG8_SB(b, h) ((4 + (b) * 2 + (h)) * HTB)
#define PG8_STAGE(bufoff, gbase, voff) do { _Pragma("unroll") for (int _i = 0; _i < 2; ++_i) \
        __builtin_amdgcn_global_load_lds((const unsigned*)((const char*)(gbase) + (voff)[_i]), (PG8_LAS unsigned*)(lds + (bufoff) + ldsw + _i * 8192), 16, 0, 0); } while (0)
#define PG8_LDA(dst, b, h) do { _Pragma("unroll") for (int m = 0; m < 4; ++m) _Pragma("unroll") for (int k = 0; k < 2; ++k) dst[m][k] = *(const PG8_LAS bf16x8*)(lds + PG8_SA(b, h) + aoff + m * 2048 + k * 1024); } while (0)
#define PG8_LDB(dst, b, h) do { _Pragma("unroll") for (int n = 0; n < 2; ++n) _Pragma("unroll") for (int k = 0; k < 2; ++k) dst[n][k] = *(const PG8_LAS bf16x8*)(lds + PG8_SB(b, h) + boff + n * 2048 + k * 1024); } while (0)
#define PG8_MMA(ai, bj, At, Bt) do { __builtin_amdgcn_s_setprio(1); _Pragma("unroll") for (int m = 0; m < 4; ++m) _Pragma("unroll") for (int n = 0; n < 2; ++n) _Pragma("unroll") for (int k = 0; k < 2; ++k) \
        acc[ai][bj][m][n] = __builtin_amdgcn_mfma_f32_16x16x32_bf16(Bt[n][k], At[m][k], acc[ai][bj][m][n], 0, 0, 0); __builtin_amdgcn_s_setprio(0); } while (0)
#define PG8_WAIT_V(n) asm volatile("s_waitcnt vmcnt(" #n ")" ::: "memory")
#define PG8_WAIT_L(n) asm volatile("s_waitcnt lgkmcnt(" #n ")" ::: "memory")
#define PG8_BAR __builtin_amdgcn_s_barrier()
#define PG8_SCHED __builtin_amdgcn_sched_barrier(0)
    Unit cur, nxt; int ui = 0;
    if (!S.next(0, cur)) return;
    f32x4 acc[2][2][4][2];
#pragma unroll
    for (int a = 0; a < 2; ++a)
#pragma unroll
        for (int b = 0; b < 2; ++b)
#pragma unroll
            for (int m = 0; m < 4; ++m)
#pragma unroll
                for (int n = 0; n < 2; ++n) acc[a][b][m][n] = (f32x4){0.f, 0.f, 0.f, 0.f};
    bf16x8 At[4][2], B0[2][2], B1[2][2];
    const char* cA = (const char*)g.A + (size_t)cur.pm * tstep; const char* cB = (const char*)g.Bt + (size_t)cur.pn * tstep;
    S.a_ready(cur);
    if constexpr (SP2) {
        PG8_STAGE(PG8_SB(0, 0), cB, voffB); PG8_STAGE(PG8_SB(0, 1), cB + hstep, voffB); PG8_STAGE(PG8_SA(0, 0), cA, voffA); PG8_STAGE(PG8_SA(0, 1), cA + hstep, voffA);
        if (wr == 1) PG8_BAR;
        PG8_WAIT_V(2); PG8_BAR;
        PG8_STAGE(PG8_SB(1, 0), cB + kstep, voffB); PG8_STAGE(PG8_SA(1, 0), cA + kstep, voffA); PG8_STAGE(PG8_SB(1, 1), cB + hstep + kstep, voffB);
        PG8_WAIT_V(6); PG8_BAR;
    } else {
        PG8_STAGE(PG8_SB(0, 0), cB, voffB); PG8_STAGE(PG8_SA(0, 0), cA, voffA); PG8_STAGE(PG8_SB(0, 1), cB + hstep, voffB); PG8_STAGE(PG8_SA(0, 1), cA + hstep, voffA);
        if (wr == 1) PG8_BAR;
        PG8_WAIT_V(4); PG8_BAR;
        PG8_STAGE(PG8_SB(1, 0), cB + kstep, voffB); PG8_STAGE(PG8_SA(1, 0), cA + kstep, voffA); PG8_STAGE(PG8_SB(1, 1), cB + hstep + kstep, voffB);
        PG8_WAIT_V(6); PG8_BAR;
    }
    for (;;) {
        const bool has_next = S.next(ui + 1, nxt);
        const char* nA = has_next ? (const char*)g.A + (size_t)nxt.pm * tstep : cA; const char* nB = has_next ? (const char*)g.Bt + (size_t)nxt.pn * tstep : cB;
        for (int t = 0; t < nt; t += 2) {
            const bool last = (t == nt - 2);
            const char* a1 = cA + (size_t)(t + 1) * kstep;
            const char* a2 = last ? nA : cA + (size_t)(t + 2) * kstep; const char* b2 = last ? nB : cB + (size_t)(t + 2) * kstep;
            const char* a3 = a2 + kstep; const char* b3 = b2 + kstep;
            if (last && has_next) S.a_ready(nxt);
            if constexpr (SP2) {
            PG8_LDB(B0, 0, 0); PG8_LDB(B1, 0, 1); PG8_SCHED; PG8_LDA(At, 0, 0); PG8_STAGE(PG8_SA(1, 1), a1 + hstep, voffA);
            PG8_WAIT_V(8); PG8_WAIT_L(0); PG8_BAR; PG8_MMA(0, 0, At, B0); PG8_MMA(0, 1, At, B1); PG8_BAR; PG8_SCHED;
            PG8_LDA(At, 0, 1); PG8_STAGE(PG8_SB(0, 0), b2, voffB); PG8_STAGE(PG8_SB(0, 1), b2 + hstep, voffB); PG8_STAGE(PG8_SA(0, 0), a2, voffA);
            PG8_WAIT_V(8); PG8_WAIT_L(0); PG8_BAR; PG8_MMA(1, 0, At, B0); PG8_MMA(1, 1, At, B1); PG8_BAR; PG8_SCHED;
            PG8_LDB(B0, 1, 0); PG8_LDB(B1, 1, 1); PG8_SCHED; PG8_LDA(At, 1, 0); PG8_STAGE(PG8_SA(0, 1), a2 + hstep, voffA);
            PG8_WAIT_V(8); PG8_WAIT_L(0); PG8_BAR; PG8_MMA(0, 0, At, B0); PG8_MMA(0, 1, At, B1); PG8_BAR; PG8_SCHED;
            PG8_LDA(At, 1, 1); PG8_STAGE(PG8_SB(1, 0), b3, voffB); PG8_STAGE(PG8_SB(1, 1), b3 + hstep, voffB); PG8_STAGE(PG8_SA(1, 0), a3, voffA);
            PG8_WAIT_V(8); PG8_WAIT_L(0); PG8_BAR; PG8_MMA(1, 0, At, B0); PG8_MMA(1, 1, At, B1); PG8_BAR; PG8_SCHED;
            } else {
            PG8_LDB(B0, 0, 0); PG8_SCHED; PG8_LDA(At, 0, 0); PG8_STAGE(PG8_SA(1, 1), a1 + hstep, voffA);
            PG8_WAIT_L(8); PG8_BAR; PG8_WAIT_L(0); PG8_MMA(0, 0, At, B0); PG8_BAR; PG8_SCHED;
            PG8_LDB(B1, 0, 1); PG8_STAGE(PG8_SB(0, 0), b2, voffB);
            PG8_BAR; PG8_WAIT_L(0); PG8_MMA(0, 1, At, B1); PG8_BAR;
            PG8_LDA(At, 0, 1); PG8_STAGE(PG8_SA(0, 0), a2, voffA);
            PG8_BAR; PG8_WAIT_L(0); PG8_MMA(1, 0, At, B0); PG8_BAR; PG8_SCHED;
            PG8_STAGE(PG8_SB(0, 1), b2 + hstep, voffB);
            PG8_WAIT_V(6); PG8_BAR; PG8_MMA(1, 1, At, B1); PG8_BAR;
            PG8_LDB(B0, 1, 0); PG8_SCHED; PG8_LDA(At, 1, 0); PG8_STAGE(PG8_SA(0, 1), a2 + hstep, voffA);
            PG8_WAIT_L(8); PG8_BAR; PG8_WAIT_L(0); PG8_MMA(0, 0, At, B0); PG8_BAR; PG8_SCHED;
            PG8_LDB(B1, 1, 1); PG8_STAGE(PG8_SB(1, 0), b3, voffB);
            PG8_BAR; PG8_WAIT_L(0); PG8_MMA(0, 1, At, B1); PG8_BAR;
            PG8_LDA(At, 1, 1); PG8_STAGE(PG8_SA(1, 0), a3, voffA);
            PG8_BAR; PG8_WAIT_L(0); PG8_MMA(1, 0, At, B0); PG8_BAR; PG8_SCHED;
            PG8_STAGE(PG8_SB(1, 1), b3 + hstep, voffB);
            PG8_WAIT_V(6); PG8_BAR; PG8_MMA(1, 1, At, B1); PG8_BAR;
            }
        }
        if constexpr (ALIGN_EPI) { if (wr == 0) PG8_BAR; }
        if constexpr (!Epi::AFTER_DRAIN) { E(acc, cur, wr, wc, fr, fq); S.done(cur); }
        if (!has_next) break;
#pragma unroll
        for (int a = 0; a < 2; ++a)
#pragma unroll
            for (int b = 0; b < 2; ++b)
#pragma unroll
                for (int m = 0; m < 4; ++m)
#pragma unroll
                    for (int n = 0; n < 2; ++n) acc[a][b][m][n] = (f32x4){0.f, 0.f, 0.f, 0.f};
        cur = nxt; cA = nA; cB = nB; ++ui;
        if constexpr (ALIGN_EPI) { if (wr == 1) PG8_BAR; }
    }
    PG8_WAIT_V(0);
    if constexpr (!ALIGN_EPI) { if (wr == 0) PG8_BAR; }
    PG8_BAR;
    if constexpr (Epi::AFTER_DRAIN) { E.fused(acc, cur, wr, wc, fr, fq, lds, wid, lane); S.done(cur); }
#undef PG8_SA
#undef PG8_SB
#undef PG8_STAGE
#undef PG8_LDA
#undef PG8_LDB
#undef PG8_MMA
#undef PG8_WAIT_V
#undef PG8_WAIT_L
#undef PG8_BAR
#undef PG8_SCHED
}
}
#define XB_TMO      128
#define XB_XCNT(j)  (256  + 64 * (j))
#define XB_XSUB(j)  (1280 + 64 * (j))
#define XB_XGEN(j)  (2304 + 64 * (j))
#define XB_TOP      3328
#define XB_TOPGEN   3392
#define XCD_BAR_WORDS 3456
#define XB_SPIN_CAP (1u << 18)
#define LAS __attribute__((address_space(3)))

__device__ __forceinline__ unsigned xb_ld(unsigned* p)              { return __hip_atomic_load(p, __ATOMIC_RELAXED, __HIP_MEMORY_SCOPE_AGENT); }
__device__ __forceinline__ unsigned xb_add(unsigned* p, unsigned v) { return __hip_atomic_fetch_add(p, v, __ATOMIC_RELAXED, __HIP_MEMORY_SCOPE_AGENT); }
__device__ __forceinline__ unsigned xb_xcc_id() { return (unsigned)__builtin_amdgcn_s_getreg((3 << 11) | 20) & 0xFu; }
#define XB_SPIN(cond, bar) do { unsigned _sp = 0; while (cond) { __builtin_amdgcn_s_sleep(1); \
    if ((++_sp & 255u) == 0u) { if (xb_ld(&(bar)[XB_TMO])) break; if (_sp > XB_SPIN_CAP) { atomicAdd(&(bar)[XB_TMO], 1u); break; } } } } while (0)

struct XcdBarrier {
    unsigned* bar; unsigned x;
    volatile LAS unsigned* st;
};

__device__ __forceinline__ XcdBarrier xcd_barrier_post(unsigned* bar, volatile LAS unsigned* st) {
    XcdBarrier b; b.bar = bar; b.x = xb_xcc_id(); b.st = st;
    if (threadIdx.x == 0) (void)xb_add(&bar[XB_XCNT(b.x)], 1u);
    return b;
}
__device__ __forceinline__ void xcd_barrier_complete(unsigned* bar, unsigned x, unsigned& nloc, unsigned& nx) {
    const unsigned G = gridDim.x * gridDim.y * gridDim.z;
    unsigned sum, cnt, mine, sp = 0u;
    for (;;) {
        sum = 0u; cnt = 0u; mine = 0u;
#pragma unroll
        for (unsigned j = 0; j < 16; ++j) { const unsigned c = xb_ld(&bar[XB_XCNT(j)]); sum += c; cnt += (c > 0u) ? 1u : 0u; mine = (j == x) ? c : mine; }
        if (sum == G) break;
        __builtin_amdgcn_s_sleep(1);
        if ((++sp & 255u) == 0u) { if (xb_ld(&bar[XB_TMO])) break; if (sp > XB_SPIN_CAP) { atomicAdd(&bar[XB_TMO], 1u); break; } }
    }
    nloc = mine > 0u ? mine : 1u; nx = cnt > 0u ? cnt : 1u;
}

__device__ __forceinline__ void xcd_barrier(const XcdBarrier& b) {
    asm volatile("s_waitcnt vmcnt(0)" ::: "memory");
    __syncthreads();
    if (threadIdx.x == 0) {
        unsigned* bar = b.bar;
        __builtin_amdgcn_s_waitcnt(0);
        unsigned nloc = b.st[0], nx = b.st[1];
        if (nloc == 0u) { xcd_barrier_complete(bar, b.x, nloc, nx); b.st[0] = nloc; b.st[1] = nx; }
        const unsigned old = xb_add(&bar[XB_XSUB(b.x)], 1u);
        const unsigned gen = old / nloc;
        if (old + 1u == (gen + 1u) * nloc) {
            __builtin_amdgcn_fence(__ATOMIC_RELEASE, "agent");
            asm volatile("s_waitcnt vmcnt(0)" ::: "memory");
            const unsigned og = xb_add(&bar[XB_TOP], 1u);
            const unsigned tg = og / nx;
            if (og + 1u == (tg + 1u) * nx) xb_add(&bar[XB_TOPGEN], 1u);
            else XB_SPIN(xb_ld(&bar[XB_TOPGEN]) == tg, bar);
            __builtin_amdgcn_fence(__ATOMIC_ACQUIRE, "agent");
            xb_add(&bar[XB_XGEN(b.x)], 1u);
            asm volatile("s_waitcnt vmcnt(0)" ::: "memory");
        } else {
            XB_SPIN(xb_ld(&bar[XB_XGEN(b.x)]) == gen, bar);
            __builtin_amdgcn_fence(__ATOMIC_ACQUIRE, "agent");
            asm volatile("s_waitcnt vmcnt(0)" ::: "memory");
        }
    }
    __syncthreads();
}

namespace cg = cooperative_groups;
namespace mk {
using pg8::bf16_t; using pg8::bf16x8; using pg8::f32x4; using pg8::u32x4; using pg8::Unit; using pg8::Gemm;
typedef float f32x16 __attribute__((ext_vector_type(16)));
typedef float f32x2 __attribute__((ext_vector_type(2)));
typedef unsigned u32x2 __attribute__((ext_vector_type(2)));
typedef __bf16 bf16x2_t __attribute__((ext_vector_type(2)));

constexpr int D = 1024, NB = 8, S = 4096, M = NB * S, NT = 512;
constexpr float EPS = 1e-6f, LOG2E = 1.4426950408889634f, QSCALE = 0.125f * 1.4426950408889634f;
constexpr size_t MiB = 1ull << 20;
constexpr size_t WS_MOD = 0;
constexpr size_t WS_BAR = 200704;
constexpr size_t WS_W0A = 256 * 1024;
constexpr size_t WS_WV  = WS_W0A + 10 * MiB;
constexpr size_t WS_WO0 = WS_WV + 2 * MiB;
constexpr size_t WS_WP  = WS_WO0 + 4 * MiB;
constexpr size_t WS_W1  = WS_WP + MiB / 2;
constexpr size_t WS_WO1 = WS_W1 + 16 * MiB;
constexpr size_t WS_H   = WS_WO1 + 4 * MiB;
constexpr size_t WS_BIG = WS_H + 64 * MiB;
constexpr size_t WS_U = WS_BIG, WS_Q = WS_BIG + 64 * MiB, WS_K = WS_BIG + 128 * MiB, WS_VT = WS_BIG + 192 * MiB, WS_G = WS_BIG + 256 * MiB;
constexpr size_t WS_UP = WS_BIG, WS_G1 = WS_BIG + 128 * MiB;
constexpr size_t WS_END = WS_BIG + 384 * MiB;

struct Args { const float* in[14]; float* out; unsigned char* ws; int ph_lo, ph_hi; };

#define MK_DI __device__ __forceinline__
MK_DI unsigned pk(float lo, float hi) { f32x2 v = {lo, hi}; return __builtin_bit_cast(unsigned, __builtin_convertvector(v, bf16x2_t)); }
MK_DI float bflo(unsigned w) { return __uint_as_float(w << 16); }
MK_DI float bfhi(unsigned w) { return __uint_as_float(w & 0xffff0000u); }
MK_DI float silu_f(float v) { return v * __builtin_amdgcn_rcpf(1.0f + __builtin_amdgcn_exp2f(-v * LOG2E)); }
MK_DI void unpack8(const u32x4 w, float (&f)[8]) { f[0] = bflo(w.x); f[1] = bfhi(w.x); f[2] = bflo(w.y); f[3] = bfhi(w.y); f[4] = bflo(w.z); f[5] = bfhi(w.z); f[6] = bflo(w.w); f[7] = bfhi(w.w); }
MK_DI u32x4 pack8(const float (&f)[8]) { u32x4 w; w.x = pk(f[0], f[1]); w.y = pk(f[2], f[3]); w.z = pk(f[4], f[5]); w.w = pk(f[6], f[7]); return w; }

MK_DI void p0_adaln(const float* c, const float* ada_w, const float* ada_b, float* mod, float* sm) {
    const int tid = threadIdx.x;
    for (int blk = blockIdx.x; blk < 192; blk += gridDim.x) {
        for (int i = tid; i < 8192; i += NT) sm[i] = silu_f(c[i]);
        __syncthreads();
        const int col = tid & 31, ks = tid >> 5;
        const int gcn = blk * 32 + col, l = gcn / 3072, n = gcn % 3072;
        float acc[8];
#pragma unroll
        for (int b = 0; b < 8; ++b) acc[b] = 0.f;
        const float* w = ada_w + (size_t)l * 1024 * 3072 + n;
        for (int kk0 = 0; kk0 < 64; kk0 += 16) {
            float wv[16];
#pragma unroll
            for (int u = 0; u < 16; ++u) wv[u] = w[(size_t)(ks + 16 * (kk0 + u)) * 3072];
#pragma unroll
            for (int u = 0; u < 16; ++u) {
                const int k = ks + 16 * (kk0 + u);
#pragma unroll
                for (int b = 0; b < 8; ++b) acc[b] += sm[b * 1024 + k] * wv[u];
            }
        }
        float* red = sm + 8192;
#pragma unroll
        for (int b = 0; b < 8; ++b) red[(ks * 32 + col) * 8 + b] = acc[b];
        __syncthreads();
        if (tid < 256) {
            const int cc = tid & 31, b = tid >> 5; float s = 0.f;
            for (int k2 = 0; k2 < 16; ++k2) s += red[(k2 * 32 + cc) * 8 + b];
            const int g2 = blk * 32 + cc, l2 = g2 / 3072, n2 = g2 % 3072;
            mod[(l2 * 8 + b) * 3072 + n2] = s + ada_b[l2 * 3072 + n2];
        }
        __syncthreads();
    }
}

MK_DI void p0_transpose(const Args& a, float* sm) {
    const int tid = threadIdx.x;
    unsigned char* ws = a.ws;
    for (int t = blockIdx.x; t < 1168; t += gridDim.x) {
        const float* src; bf16_t* dst; int ld, K, tn, tk, mode;
        if (t < 320)       { src = a.in[5];  ld = 6144; K = 1024; tn = t >> 2; tk = t & 3; mode = 0; dst = (bf16_t*)(ws + WS_W0A); }
        else if (t < 384)  { const int u = t - 320; src = a.in[5] + 3072; ld = 6144; K = 1024; tn = u >> 2; tk = u & 3; mode = 1; dst = (bf16_t*)(ws + WS_WV); }
        else if (t < 512)  { const int u = t - 384; src = a.in[8];  ld = 1024; K = 2048; tn = u >> 3; tk = u & 7; mode = 1; dst = (bf16_t*)(ws + WS_WO0); }
        else if (t < 528)  { const int u = t - 512, g = u >> 2; src = a.in[6] + g * 65536; ld = 256; K = 256; tn = u & 3; tk = 0; mode = 1; dst = (bf16_t*)(ws + WS_WP) + g * 65536; }
        else if (t < 1040) { const int u = t - 528; src = a.in[9];  ld = 8192; K = 1024; tn = u >> 2; tk = u & 3; mode = 2; dst = (bf16_t*)(ws + WS_W1); }
        else               { const int u = t - 1040; src = a.in[12]; ld = 1024; K = 2048; tn = u >> 3; tk = u & 7; mode = 1; dst = (bf16_t*)(ws + WS_WO1); }
        const int nn = tid & 63, n1 = tn * 64 + nn, kr = tid >> 6;
        int col;
        if (mode == 0) col = n1 < 3072 ? n1 : n1 + 1024;
        else if (mode == 1) col = n1;
        else { const int pn = n1 >> 8, bj = (n1 >> 7) & 1, wc = (n1 >> 5) & 3, n = (n1 >> 4) & 1, fq = (n1 >> 2) & 3, j = n1 & 3; col = (2 * bj + n) * 2048 + 64 * pn + 16 * wc + 4 * fq + j; }
        const float* sp = src + (size_t)(tk * 256 + kr) * ld + col;
        float v[32];
#pragma unroll
        for (int e = 0; e < 32; ++e) v[e] = sp[(size_t)(8 * e) * ld];
#pragma unroll
        for (int e = 0; e < 32; ++e) sm[nn * 257 + kr + 8 * e] = v[e];
        __syncthreads();
#pragma unroll
        for (int i = 0; i < 4; ++i) {
            const int p = tid + 512 * i, wn = p & 63, kc = (p >> 6) * 8;
            float f[8];
#pragma unroll
            for (int j = 0; j < 8; ++j) f[j] = sm[wn * 257 + kc + j];
            *(u32x4*)(dst + (size_t)(tn * 64 + wn) * K + tk * 256 + kc) = pack8(f);
        }
        __syncthreads();
    }
}

MK_DI float wave_sum(float v) {
#pragma unroll
    for (int off = 32; off >= 1; off >>= 1) v += __shfl_xor(v, off);
    return v;
}
MK_DI void p_norm_mod(const float* xin, const float* g, const float* modl, bf16_t* H) {
    const int tid = threadIdx.x, lane = tid & 63, wid = tid >> 6, stride = gridDim.x * 8;
    for (int rowa = blockIdx.x * 8 + wid; rowa < M; rowa += 2 * stride) {
        const bool ok1 = rowa + stride < M;
        int rows[2]; rows[0] = rowa; rows[1] = ok1 ? rowa + stride : rowa;
        f32x4 v[2][4];
#pragma unroll
        for (int q = 0; q < 2; ++q)
#pragma unroll
            for (int j = 0; j < 4; ++j) v[q][j] = *(const f32x4*)(xin + (size_t)rows[q] * D + 4 * lane + 256 * j);
#pragma unroll
        for (int q = 0; q < 2; ++q) {
            float ss = 0.f;
#pragma unroll
            for (int j = 0; j < 4; ++j) ss += v[q][j].x * v[q][j].x + v[q][j].y * v[q][j].y + v[q][j].z * v[q][j].z + v[q][j].w * v[q][j].w;
            ss = wave_sum(ss);
            const float rstd = rsqrtf(ss * (1.0f / 1024.0f) + EPS);
            const float* mb = modl + (rows[q] >> 12) * 3072 + 4 * lane;
            if (q == 0 || ok1) {
#pragma unroll
                for (int j = 0; j < 4; ++j) {
                    const f32x4 gv = *(const f32x4*)(g + 4 * lane + 256 * j), sh = *(const f32x4*)(mb + 256 * j), sc = *(const f32x4*)(mb + 1024 + 256 * j);
                    const f32x4 hh = (v[q][j] * rstd) * gv * (sc + 1.0f) + sh;
                    u32x2 w; w.x = pk(hh.x, hh.y); w.y = pk(hh.z, hh.w);
                    *(u32x2*)(H + (size_t)rows[q] * D + 4 * lane + 256 * j) = w;
                }
            }
        }
    }
}
MK_DI void p_final_norm(float* xo, const float* g) {
    const int tid = threadIdx.x, lane = tid & 63, wid = tid >> 6, stride = gridDim.x * 8;
    for (int rowa = blockIdx.x * 8 + wid; rowa < M; rowa += 2 * stride) {
        const bool ok1 = rowa + stride < M;
        int rows[2]; rows[0] = rowa; rows[1] = ok1 ? rowa + stride : rowa;
        f32x4 v[2][4];
#pragma unroll
        for (int q = 0; q < 2; ++q)
#pragma unroll
            for (int j = 0; j < 4; ++j) v[q][j] = *(const f32x4*)(xo + (size_t)rows[q] * D + 4 * lane + 256 * j);
#pragma unroll
        for (int q = 0; q < 2; ++q) {
            float ss = 0.f;
#pragma unroll
            for (int j = 0; j < 4; ++j) ss += v[q][j].x * v[q][j].x + v[q][j].y * v[q][j].y + v[q][j].z * v[q][j].z + v[q][j].w * v[q][j].w;
            ss = wave_sum(ss);
            const float rstd = rsqrtf(ss * (1.0f / 1024.0f) + EPS);
            if (q == 0 || ok1) {
#pragma unroll
                for (int j = 0; j < 4; ++j) { const f32x4 gv = *(const f32x4*)(g + 4 * lane + 256 * j); *(f32x4*)(xo + (size_t)rows[q] * D + 4 * lane + 256 * j) = (v[q][j] * rstd) * gv; }
            }
        }
    }
}

struct EpiProj0 {
    static constexpr bool PERM = true, AFTER_DRAIN = false;
    bf16_t *U, *Q, *Kh, *G;
    MK_DI void operator()(const f32x4 (&acc)[2][2][4][2], const Unit& u, int wr, int wc, int fr, int fq) const {
        const int reg = u.pn >> 2, row0 = u.pm * 256 + wr * 64 + fr, cb = u.pn * 256 + wc * 32 + 8 * fq;
#pragma unroll
        for (int ai = 0; ai < 2; ++ai)
#pragma unroll
            for (int m = 0; m < 4; ++m) {
                const int row = row0 + ai * 128 + m * 16;
#pragma unroll
                for (int bj = 0; bj < 2; ++bj) {
                    const int c = cb + bj * 128; f32x4 v0 = acc[ai][bj][m][0], v1 = acc[ai][bj][m][1]; bf16_t* ptr;
                    if (reg == 0) ptr = U + (size_t)row * 1024 + c;
                    else if (reg == 1) { v0 *= QSCALE; v1 *= QSCALE; ptr = Q + (size_t)row * 1024 + (c - 1024); }
                    else if (reg == 2) { const int cc = c - 2048; ptr = Kh + ((size_t)((row >> 12) * 16 + (cc >> 6)) * 4096 + (row & 4095)) * 64 + (cc & 63); }
                    else { v0.x = silu_f(v0.x); v0.y = silu_f(v0.y); v0.z = silu_f(v0.z); v0.w = silu_f(v0.w); v1.x = silu_f(v1.x); v1.y = silu_f(v1.y); v1.z = silu_f(v1.z); v1.w = silu_f(v1.w);
                           ptr = G + (size_t)row * 2048 + (c - 3072); }
                    u32x4 w; w.x = pk(v0.x, v0.y); w.y = pk(v0.z, v0.w); w.z = pk(v1.x, v1.y); w.w = pk(v1.z, v1.w);
                    *(u32x4*)ptr = w;
                }
            }
    }
};
struct EpiVt {
    static constexpr bool PERM = true, AFTER_DRAIN = false;
    bf16_t* Vt;
    MK_DI void operator()(const f32x4 (&acc)[2][2][4][2], const Unit& u, int wr, int wc, int fr, int fq) const {
        const int row0 = u.pm * 256 + wr * 64 + fr, cb = u.pn * 256 + wc * 32 + 8 * fq;
#pragma unroll
        for (int ai = 0; ai < 2; ++ai)
#pragma unroll
            for (int m = 0; m < 4; ++m) {
                const int row = row0 + ai * 128 + m * 16;
#pragma unroll
                for (int bj = 0; bj < 2; ++bj) {
                    const f32x4 v0 = acc[ai][bj][m][0], v1 = acc[ai][bj][m][1];
                    u32x4 w; w.x = pk(v0.x, v0.y); w.y = pk(v0.z, v0.w); w.z = pk(v1.x, v1.y); w.w = pk(v1.z, v1.w);
                    *(u32x4*)(Vt + (size_t)row * 32768 + cb + bj * 128) = w;
                }
            }
    }
};
struct EpiRes {
    static constexpr bool PERM = false, AFTER_DRAIN = false;
    const float* res; float* out; const float* gate;
    MK_DI void operator()(const f32x4 (&acc)[2][2][4][2], const Unit& u, int wr, int wc, int fr, int fq) const {
        const int row0 = u.pm * 256 + wr * 64 + fr, col0 = u.pn * 256 + wc * 32 + 4 * fq, b = (u.pm * 256) >> 12;
        f32x4 gv[2][2];
#pragma unroll
        for (int bj = 0; bj < 2; ++bj)
#pragma unroll
            for (int n = 0; n < 2; ++n) gv[bj][n] = *(const f32x4*)(gate + b * 3072 + col0 + bj * 128 + n * 16) + 1.0f;
#pragma unroll
        for (int ai = 0; ai < 2; ++ai)
#pragma unroll
            for (int m = 0; m < 4; ++m) {
                const size_t off = (size_t)(row0 + ai * 128 + m * 16) * 1024 + col0;
#pragma unroll
                for (int bj = 0; bj < 2; ++bj)
#pragma unroll
                    for (int n = 0; n < 2; ++n) { const size_t o = off + bj * 128 + n * 16; const f32x4 r = *(const f32x4*)(res + o); *(f32x4*)(out + o) = r + gv[bj][n] * acc[ai][bj][m][n]; }
            }
    }
};
struct EpiGate {
    static constexpr bool PERM = false, AFTER_DRAIN = false;
    bf16_t *UP, *G1;
    MK_DI void operator()(const f32x4 (&acc)[2][2][4][2], const Unit& u, int wr, int wc, int fr, int fq) const {
        const int row0 = u.pm * 256 + wr * 64 + fr, ch0 = u.pn * 64 + wc * 16 + 4 * fq;
#pragma unroll
        for (int ai = 0; ai < 2; ++ai)
#pragma unroll
            for (int m = 0; m < 4; ++m) {
                const size_t off = (size_t)(row0 + ai * 128 + m * 16) * 2048 + ch0;
                const f32x4 gb = acc[ai][0][m][0], gc = acc[ai][0][m][1], uu = acc[ai][1][m][0], gt = acc[ai][1][m][1];
                const f32x4 up = gc * uu;
                f32x4 gg; gg.x = gb.x * silu_f(gt.x); gg.y = gb.y * silu_f(gt.y); gg.z = gb.z * silu_f(gt.z); gg.w = gb.w * silu_f(gt.w);
                u32x2 w0, w1; w0.x = pk(up.x, up.y); w0.y = pk(up.z, up.w); w1.x = pk(gg.x, gg.y); w1.y = pk(gg.z, gg.w);
                *(u32x2*)(UP + off) = w0; *(u32x2*)(G1 + off) = w1;
            }
    }
};
struct EpiPool {
    static constexpr bool PERM = true, AFTER_DRAIN = false;
    bf16_t* G; const float* pscale;
    MK_DI void operator()(const f32x4 (&acc)[2][2][4][2], const Unit& u, int wr, int wc, int fr, int fq) const {
        const int row0 = (u.pm & 127) * 256 + wr * 64 + fr, cb = u.pn * 256 + wc * 32 + 8 * fq;
        f32x4 ps[2][2];
#pragma unroll
        for (int bj = 0; bj < 2; ++bj) { ps[bj][0] = *(const f32x4*)(pscale + cb + bj * 128); ps[bj][1] = *(const f32x4*)(pscale + cb + bj * 128 + 4); }
#pragma unroll
        for (int ai = 0; ai < 2; ++ai)
#pragma unroll
            for (int m = 0; m < 4; ++m) {
                const int row = row0 + ai * 128 + m * 16;
#pragma unroll
                for (int bj = 0; bj < 2; ++bj) {
                    bf16_t* ptr = G + (size_t)row * 2048 + cb + bj * 128;
                    const u32x4 gw = *(const u32x4*)ptr;
                    const f32x4 v0 = acc[ai][bj][m][0] * ps[bj][0], v1 = acc[ai][bj][m][1] * ps[bj][1];
                    u32x4 w; w.x = pk(v0.x * bflo(gw.x), v0.y * bfhi(gw.x)); w.y = pk(v0.z * bflo(gw.y), v0.w * bfhi(gw.y));
                    w.z = pk(v1.x * bflo(gw.z), v1.y * bfhi(gw.z)); w.w = pk(v1.z * bflo(gw.w), v1.w * bfhi(gw.w));
                    *(u32x4*)ptr = w;
                }
            }
    }
};
struct PoolSched {
    int G, c;
    __device__ bool next(int i, Unit& u) const { const int L = i * G + c; if (L >= 512) return false; u.pm = L; u.pn = L >> 7; return true; }
    MK_DI void a_ready(const Unit&) const {}
    MK_DI void done(const Unit&) const {}
};

MK_DI void p_pool_prep(const bf16_t* U, bf16_t* P) {
    for (int item = blockIdx.x * NT + threadIdx.x; item < 1024 * 128; item += gridDim.x * NT) {
        const int chunk = item & 127, tb = item >> 7, g = chunk >> 5, w = 2 << g, t0 = tb * 32, pos0 = t0 & 4095;
        const bf16_t* up = U + (size_t)t0 * 1024 + chunk * 8;
        bf16_t* pp = P + ((size_t)g * 32768 + t0) * 256 + (chunk & 31) * 8;
        float s[8];
#pragma unroll
        for (int i = 0; i < 8; ++i) s[i] = 0.f;
        for (int i = 1; i < w; ++i) if (pos0 - i >= 0) { float f[8]; unpack8(*(const u32x4*)(up - (ptrdiff_t)i * 1024), f);
#pragma unroll
            for (int e = 0; e < 8; ++e) s[e] += f[e]; }
        for (int tt = 0; tt < 32; ++tt) {
            float cur[8], p[8]; unpack8(*(const u32x4*)(up + (size_t)tt * 1024), cur);
            const int cnt = (pos0 + tt + 1) < w ? (pos0 + tt + 1) : w; const float inv = 1.0f / (float)cnt;
#pragma unroll
            for (int e = 0; e < 8; ++e) { s[e] += cur[e]; p[e] = s[e] * inv - cur[e]; }
            *(u32x4*)(pp + (size_t)tt * 256) = pack8(p);
            const int old = tt - (w - 1);
            if (pos0 + old >= 0) { float f[8]; unpack8(*(const u32x4*)(up + (ptrdiff_t)old * 1024), f);
#pragma unroll
                for (int e = 0; e < 8; ++e) s[e] -= f[e]; }
        }
    }
}

#define MK_MFMA32(a, b, c) __builtin_amdgcn_mfma_f32_32x32x16_bf16((a), (b), (c), 0, 0, 0)
MK_DI void p_attn(const bf16_t* Q, const bf16_t* Kh, const bf16_t* Vt, bf16_t* G) {
    const int tid = threadIdx.x, lane = tid & 63, wid = tid >> 6, r = lane & 31, h = lane >> 5;
    const int pr = (r & 0x13) | ((r & 4) << 1) | ((r & 8) >> 1);
    for (int unit = blockIdx.x * 8 + wid; unit < 16384; unit += gridDim.x * 8) {
        const int qb = unit & 127, head = (unit >> 7) & 15, b = unit >> 11, q0 = qb * 32;
        const bf16_t* qp = Q + (size_t)(b * 4096 + q0 + r) * 1024 + head * 64 + 8 * h;
        bf16x8 qf[4];
#pragma unroll
        for (int kk = 0; kk < 4; ++kk) qf[kk] = *(const bf16x8*)(qp + 16 * kk);
        const bf16_t* kbase = Kh + ((size_t)(b * 16 + head) * 4096 + pr) * 64 + 8 * h;
        const bf16_t* vbase = Vt + (size_t)(head * 64 + r) * 32768 + b * 4096 + 8 * h;
        f32x16 o0, o1;
#pragma unroll
        for (int i = 0; i < 16; ++i) { o0[i] = 0.f; o1[i] = 0.f; }
        float carry = 1.0f;
        bf16x8 kf[4], vf[4], kf1[4], vf1[4];
#pragma unroll
        for (int kk = 0; kk < 4; ++kk) kf[kk] = *(const bf16x8*)(kbase + (size_t)q0 * 64 + 16 * kk);
#pragma unroll
        for (int i = 0; i < 4; ++i) vf[i] = *(const bf16x8*)(vbase + (size_t)(i >> 1) * 32 * 32768 + q0 + 16 * (i & 1));
        { const int kl1 = q0 >= 32 ? q0 - 32 : 0;
#pragma unroll
          for (int kk = 0; kk < 4; ++kk) kf1[kk] = *(const bf16x8*)(kbase + (size_t)kl1 * 64 + 16 * kk);
#pragma unroll
          for (int i = 0; i < 4; ++i) vf1[i] = *(const bf16x8*)(vbase + (size_t)(i >> 1) * 32 * 32768 + kl1 + 16 * (i & 1)); }
        int k0 = q0;
        for (;;) {
            const int k1 = k0 - 32, k2 = k0 - 64, kl = k2 < 0 ? 0 : k2;
            bf16x8 kn[4], vn[4];
#pragma unroll
            for (int kk = 0; kk < 4; ++kk) kn[kk] = *(const bf16x8*)(kbase + (size_t)kl * 64 + 16 * kk);
#pragma unroll
            for (int i = 0; i < 4; ++i) vn[i] = *(const bf16x8*)(vbase + (size_t)(i >> 1) * 32 * 32768 + kl + 16 * (i & 1));
            f32x16 z;
#pragma unroll
            for (int i = 0; i < 16; ++i) z[i] = 0.f;
#pragma unroll
            for (int kk = 0; kk < 4; ++kk) z = MK_MFMA32(kf[kk], qf[kk], z);
            const bool diag = (k0 == q0);
            float ez[16], cf[16];
#pragma unroll
            for (int i = 0; i < 16; ++i) {
                const int krel = 16 * (i >> 3) + 8 * h + (i & 7);
                float zz = fminf(z[i], 100.0f);
                if (diag && krel >= r) zz = -__builtin_inff();
                ez[i] = __builtin_amdgcn_exp2f(zz);
                cf[i] = __builtin_amdgcn_rcpf(1.0f + ez[i]);
            }
#pragma unroll
            for (int i = 6; i >= 0; --i) { cf[i] *= cf[i + 1]; cf[i + 8] *= cf[i + 9]; }
            const float plo = cf[0], phi = cf[8];
            const float plo_p = __shfl_xor(plo, 32), phi_p = __shfl_xor(phi, 32);
            const float pre_hi = carry * (h == 0 ? phi_p : 1.0f);
            const float pre_lo = carry * (phi * phi_p) * (h == 0 ? plo_p : 1.0f);
            carry = carry * (plo * plo_p) * (phi * phi_p);
            float a[16];
#pragma unroll
            for (int i = 0; i < 8; ++i) { a[i] = (ez[i] * cf[i]) * pre_lo; a[i + 8] = (ez[i + 8] * cf[i + 8]) * pre_hi; }
            u32x4 w0, w1;
            w0.x = pk(a[0], a[1]); w0.y = pk(a[2], a[3]); w0.z = pk(a[4], a[5]); w0.w = pk(a[6], a[7]);
            w1.x = pk(a[8], a[9]); w1.y = pk(a[10], a[11]); w1.z = pk(a[12], a[13]); w1.w = pk(a[14], a[15]);
            const bf16x8 p0 = __builtin_bit_cast(bf16x8, w0), p1 = __builtin_bit_cast(bf16x8, w1);
            o0 = MK_MFMA32(vf[0], p0, o0); o0 = MK_MFMA32(vf[1], p1, o0);
            o1 = MK_MFMA32(vf[2], p0, o1); o1 = MK_MFMA32(vf[3], p1, o1);
            if (k1 < 0) break;
            if (__all(carry < 1e-37f)) break;
#pragma unroll
            for (int i = 0; i < 4; ++i) { kf[i] = kf1[i]; vf[i] = vf1[i]; kf1[i] = kn[i]; vf1[i] = vn[i]; }
            k0 = k1;
        }
        bf16_t* gp = G + (size_t)(b * 4096 + q0 + r) * 2048 + 1024 + head * 64 + 4 * h;
#pragma unroll
        for (int g4 = 0; g4 < 4; ++g4) {
            { u32x2* p = (u32x2*)(gp + 8 * g4); const u32x2 gw = *p; u32x2 w;
              w.x = pk(o0[4 * g4] * bflo(gw.x), o0[4 * g4 + 1] * bfhi(gw.x)); w.y = pk(o0[4 * g4 + 2] * bflo(gw.y), o0[4 * g4 + 3] * bfhi(gw.y)); *p = w; }
            { u32x2* p = (u32x2*)(gp + 32 + 8 * g4); const u32x2 gw = *p; u32x2 w;
              w.x = pk(o1[4 * g4] * bflo(gw.x), o1[4 * g4 + 1] * bfhi(gw.x)); w.y = pk(o1[4 * g4 + 2] * bflo(gw.y), o1[4 * g4 + 3] * bfhi(gw.y)); *p = w; }
        }
    }
}

MK_DI void p_conv(const bf16_t* UP, bf16_t* G1, const float* cw, const float* cbias) {
    for (int item = blockIdx.x * NT + threadIdx.x; item < 2048 * 256; item += gridDim.x * NT) {
        const int chunk = item & 255, tb = item >> 8, t0 = tb * 16, pos0 = t0 & 4095, c0 = chunk * 8;
        float w0[8], w1[8], w2[8], bb[8], um2[8], um1[8];
#pragma unroll
        for (int e = 0; e < 8; ++e) { w0[e] = cw[c0 + e]; w1[e] = cw[2048 + c0 + e]; w2[e] = cw[4096 + c0 + e]; bb[e] = cbias[c0 + e]; um2[e] = 0.f; um1[e] = 0.f; }
        const bf16_t* up = UP + (size_t)t0 * 2048 + c0; bf16_t* gp = G1 + (size_t)t0 * 2048 + c0;
        if (pos0 != 0) { unpack8(*(const u32x4*)(up - 4096), um2); unpack8(*(const u32x4*)(up - 2048), um1); }
        for (int tt = 0; tt < 16; ++tt) {
            float cur[8], gg[8], y[8];
            unpack8(*(const u32x4*)(up + (size_t)tt * 2048), cur); unpack8(*(const u32x4*)(gp + (size_t)tt * 2048), gg);
#pragma unroll
            for (int e = 0; e < 8; ++e) { y[e] = gg[e] * (bb[e] + w0[e] * um2[e] + w1[e] * um1[e] + w2[e] * cur[e]); um2[e] = um1[e]; um1[e] = cur[e]; }
            *(u32x4*)(gp + (size_t)tt * 2048) = pack8(y);
        }
    }
}

template <class Epi> MK_DI void run_gemm(PG8_LAS unsigned char* lds, const bf16_t* A, const bf16_t* Bt, int Mr, int Nc, int K, const Epi& E) {
    Gemm g; g.A = A; g.Bt = Bt; g.M = Mr; g.N = Nc; g.K = K;
    pg8::StaticOrder so; so.init(Mr, Nc, (int)gridDim.x, (int)blockIdx.x);
    pg8::gemm_phase<Epi, pg8::StaticOrder, true, true>(lds, g, so, E);
}

__global__ void __launch_bounds__(512, 2) mk_fwd(Args a) {
    extern __shared__ __attribute__((aligned(16))) unsigned char smem[];
    cg::grid_group grid = cg::this_grid();
    PG8_LAS unsigned char* lds = (PG8_LAS unsigned char*)smem;
    float* smf = (float*)smem;
    unsigned char* ws = a.ws;
    const int lo = a.ph_lo, hi = a.ph_hi;
    float* mod = (float*)(ws + WS_MOD);
    bf16_t* H = (bf16_t*)(ws + WS_H);
    bf16_t *U = (bf16_t*)(ws + WS_U), *Q = (bf16_t*)(ws + WS_Q), *Kh = (bf16_t*)(ws + WS_K), *Vt = (bf16_t*)(ws + WS_VT), *G = (bf16_t*)(ws + WS_G);
    bf16_t *UP = (bf16_t*)(ws + WS_UP), *G1 = (bf16_t*)(ws + WS_G1);
#define MK_IN(k) (lo <= (k) && (k) < hi)
    volatile LAS unsigned* xst = (volatile LAS unsigned*)(lds + 131072);
    if (threadIdx.x < 4) xst[threadIdx.x] = 0u;
    __syncthreads();
    XcdBarrier xbar = xcd_barrier_post((unsigned*)(ws + WS_BAR), xst);
    if (lo < 0) grid.sync();
#define MK_SEAM(k) do { if (MK_IN(k) && MK_IN((k) + 1)) xcd_barrier(xbar); } while (0)
    if (MK_IN(0)) { p0_adaln(a.in[1], a.in[3], a.in[4], mod, smf); p0_transpose(a, smf); }
    MK_SEAM(0);
    if (MK_IN(1)) p_norm_mod(a.in[0], a.in[2], mod, H);
    MK_SEAM(1);
    if (MK_IN(2)) {
        EpiProj0 e0; e0.U = U; e0.Q = Q; e0.Kh = Kh; e0.G = G;
        run_gemm(lds, H, (const bf16_t*)(ws + WS_W0A), M, 5120, 1024, e0);
        EpiVt e1; e1.Vt = Vt;
        run_gemm(lds, (const bf16_t*)(ws + WS_WV), H, 1024, M, 1024, e1);
    }
    MK_SEAM(2);
    if (MK_IN(3)) { p_attn(Q, Kh, Vt, G); p_pool_prep(U, H); }
    MK_SEAM(3);
    if (MK_IN(4)) {
        EpiPool e; e.G = G; e.pscale = a.in[7];
        Gemm g; g.A = H; g.Bt = (const bf16_t*)(ws + WS_WP); g.M = 4 * M; g.N = 1024; g.K = 256;
        PoolSched ps; ps.G = (int)gridDim.x; ps.c = (int)blockIdx.x;
        pg8::gemm_phase<EpiPool, PoolSched, true, true>(lds, g, ps, e);
    }
    MK_SEAM(4);
    if (MK_IN(5)) { EpiRes e; e.res = a.in[0]; e.out = a.out; e.gate = mod + 2048; run_gemm(lds, G, (const bf16_t*)(ws + WS_WO0), M, 1024, 2048, e); }
    MK_SEAM(5);
    if (MK_IN(6)) p_norm_mod(a.out, a.in[2] + 1024, mod + 8 * 3072, H);
    MK_SEAM(6);
    if (MK_IN(7)) { EpiGate e; e.UP = UP; e.G1 = G1; run_gemm(lds, H, (const bf16_t*)(ws + WS_W1), M, 8192, 1024, e); }
    MK_SEAM(7);
    if (MK_IN(8)) p_conv(UP, G1, a.in[10], a.in[11]);
    MK_SEAM(8);
    if (MK_IN(9)) { EpiRes e; e.res = a.out; e.out = a.out; e.gate = mod + 8 * 3072 + 2048; run_gemm(lds, G1, (const bf16_t*)(ws + WS_WO1), M, 1024, 2048, e); }
    MK_SEAM(9);
    if (MK_IN(10)) p_final_norm(a.out, a.in[13]);
}
}

#ifndef MK_ONE_LAUNCH
#define MK_ONE_LAUNCH 1
#endif
constexpr int MK_LDS_BYTES = 131072 + 16;
extern "C" void kernel_launch(void* const* d_in, const int* in_sizes, int n_in, void* d_out, int out_size, void* d_ws, size_t ws_size, hipStream_t stream) {
    static int grid = 0;
    if (grid == 0) {
        if (n_in != 14 || out_size != mk::M * mk::D || ws_size < mk::WS_END) { fprintf(stderr, "kernel_launch: unexpected shapes (n_in %d, out %d, ws %zu < %zu)\n", n_in, out_size, ws_size, (size_t)mk::WS_END); grid = -1; return; }
        int dev = 0, cus = 0, per_cu = 0;
        if (hipGetDevice(&dev) != hipSuccess || hipDeviceGetAttribute(&cus, hipDeviceAttributeMultiprocessorCount, dev) != hipSuccess) { grid = -1; return; }
        if (hipFuncSetAttribute((const void*)mk::mk_fwd, hipFuncAttributeMaxDynamicSharedMemorySize, MK_LDS_BYTES) != hipSuccess) { fprintf(stderr, "kernel_launch: hipFuncSetAttribute failed\n"); grid = -1; return; }
        if (hipOccupancyMaxActiveBlocksPerMultiprocessor(&per_cu, (const void*)mk::mk_fwd, 512, MK_LDS_BYTES) != hipSuccess || per_cu < 1) { per_cu = 1; (void)hipGetLastError(); }
        grid = cus;
    }
    if (grid < 0) return;
    if (hipMemsetAsync((char*)d_ws + mk::WS_BAR, 0, XCD_BAR_WORDS * sizeof(unsigned), stream) != hipSuccess) { fprintf(stderr, "kernel_launch: memset of barrier words failed\n"); return; }
    mk::Args a{};
    for (int i = 0; i < 14; ++i) a.in[i] = (const float*)d_in[i];
    a.out = (float*)d_out; a.ws = (unsigned char*)d_ws;
#if MK_ONE_LAUNCH
    a.ph_lo = 0; a.ph_hi = 11;
    void* args[] = {&a};
    hipError_t e = hipLaunchCooperativeKernel((const void*)mk::mk_fwd, dim3(grid), dim3(512), args, MK_LDS_BYTES, stream);
    if (e != hipSuccess) fprintf(stderr, "kernel_launch: cooperative launch failed: %s (grid %d)\n", hipGetErrorString(e), grid);
#else
    for (int ph = 0; ph < 11; ++ph) { a.ph_lo = ph; a.ph_hi = ph + 1; hipLaunchKernelGGL(mk::mk_fwd, dim3(grid), dim3(512), MK_LDS_BYTES, stream, a); }
#endif
}
```

```cpp
#include <hip/hip_runtime.h>
#include <hip/hip_cooperative_groups.h>
#include <cstdio>
#include <cstdint>
namespace pg8 {
#define PG8_LAS __attribute__((address_space(3)))
typedef unsigned short bf16_t;
typedef short bf16x8 __attribute__((ext_vector_type(8)));
typedef float f32x4 __attribute__((ext_vector_type(4)));
typedef unsigned u32x4 __attribute__((ext_vector_type(4)));
constexpr int BM = 256, BK = 64, HALF = 128, HTB = HALF * BK * 2  , STAGE_BYTES = 8 * HTB, NXCD = 8, WGM = 8;

__host__ __device__ __forceinline__ int lds_byte(int r, int c) { const int st = (r >> 4) * 2 + (c >> 5), rr = r & 15, cc = c & 31, ob = rr * 64 + cc * 2; return st * 1024 + (ob ^ (((ob >> 9) & 1) << 5)); }
__host__ __device__ __forceinline__ void stage_rc(int b, int& R, int& C) { const int st = b / 1024, sb = b % 1024, swz = sb ^ (((sb >> 9) & 1) << 5); R = (st >> 1) * 16 + swz / 64; C = (st & 1) * 32 + (swz % 64) / 2; }
__host__ __device__ __forceinline__ int perm32(int rho) { const int n = rho >> 4, i = rho & 15; return 8 * (i >> 2) + 4 * n + (i & 3); }

struct Unit { int pm, pn; };
struct Gemm { const bf16_t* A; const bf16_t* Bt; int M, N, K; };

struct StaticOrder {
    int nM, nN, nwg, G, c;
    __host__ __device__ void init(int M, int N, int G_, int c_) { nM = M / BM; nN = N / BM; nwg = nM * nN; G = G_; c = c_; }
    __host__ __device__ bool next(int i, Unit& u) const {
        const long L = (long)i * G + c; if (L >= nwg) return false;
        int wgid = (int)L; { const int q = nwg / NXCD, r = nwg % NXCD, xcd = wgid % NXCD, off = wgid / NXCD; wgid = (xcd < r ? xcd * (q + 1) : r * (q + 1) + (xcd - r) * q) + off; }
        const int nig = WGM * nN, gid = wgid / nig, fm = gid * WGM, gsz = (nM - fm) < WGM ? (nM - fm) : WGM;
        u.pm = fm + ((wgid % nig) % gsz); u.pn = (wgid % nig) / gsz; return true;
    }
    __device__ __forceinline__ void a_ready(const Unit&) const {}
    __device__ __forceinline__ void done(const Unit&) const {}
};
__device__ __forceinline__ unsigned cvt_pk_bf16(float lo, float hi) { unsigned r; asm volatile("v_cvt_pk_bf16_f32 %0, %1, %2" : "=v"(r) : "v"(lo), "v"(hi)); return r; }
template <class Epi, class Sched, bool ALIGN_EPI = false, bool SP2 = false>
__device__ __forceinline__ void gemm_phase(PG8_LAS unsigned char* lds, const Gemm g, const Sched& S, const Epi& E) {
    const int tid = threadIdx.x, wid = __builtin_amdgcn_readfirstlane(tid >> 6), lane = tid & 63, wr = wid >> 2, wc = wid & 3, fr = lane & 15, fq = lane >> 4;
    const int K = g.K, nt = K / BK;
    unsigned voffA[2], voffB[2];
#pragma unroll
    for (int i = 0; i < 2; ++i) { int R, C; stage_rc(tid * 16 + i * 8192, R, C); const int Rb = Epi::PERM ? ((R & ~31) + perm32(R & 31)) : R;
        voffA[i] = (unsigned)(R * K + C) * 2u; voffB[i] = (unsigned)(Rb * K + C) * 2u; }
    const size_t kstep = (size_t)(BK * 2);
    const size_t hstep = (size_t)HALF * K * 2;
    const size_t tstep = 2 * hstep;
    const unsigned ldsw = (unsigned)wid * 1024u;
    const int aoff = lds_byte(wr * 64 + fr, fq * 8), boff = lds_byte(wc * 32 + fr, fq * 8);
#define PG8_SA(b, h) (((b) * 2 + (h)) * HTB)
#define PG8_SB(b, h) ((4 + (b) * 2 + (h)) * HTB)
#define PG8_STAGE(bufoff, gbase, voff) do { _Pragma("unroll") for (int _i = 0; _i < 2; ++_i) \
        __builtin_amdgcn_global_load_lds((const unsigned*)((const char*)(gbase) + (voff)[_i]), (PG8_LAS unsigned*)(lds + (bufoff) + ldsw + _i * 8192), 16, 0, 0); } while (0)
#define PG8_LDA(dst, b, h) do { _Pragma("unroll") for (int m = 0; m < 4; ++m) _Pragma("unroll") for (int k = 0; k < 2; ++k) dst[m][k] = *(const PG8_LAS bf16x8*)(lds + PG8_SA(b, h) + aoff + m * 2048 + k * 1024); } while (0)
#define PG8_LDB(dst, b, h) do { _Pragma("unroll") for (int n = 0; n < 2; ++n) _Pragma("unroll") for (int k = 0; k < 2; ++k) dst[n][k] = *(const PG8_LAS bf16x8*)(lds + PG8_SB(b, h) + boff + n * 2048 + k * 1024); } while (0)
#define PG8_MMA(ai, bj, At, Bt) do { __builtin_amdgcn_s_setprio(1); _Pragma("unroll") for (int m = 0; m < 4; ++m) _Pragma("unroll") for (int n = 0; n < 2; ++n) _Pragma("unroll") for (int k = 0; k < 2; ++k) \
        acc[ai][bj][m][n] = __builtin_amdgcn_mfma_f32_16x16x32_bf16(Bt[n][k], At[m][k], acc[ai][bj][m][n], 0, 0, 0); __builtin_amdgcn_s_setprio(0); } while (0)
#define PG8_WAIT_V(n) asm volatile("s_waitcnt vmcnt(" #n ")" ::: "memory")
#define PG8_WAIT_L(n) asm volatile("s_waitcnt lgkmcnt(" #n ")" ::: "memory")
#define PG8_BAR __builtin_amdgcn_s_barrier()
#define PG8_SCHED __builtin_amdgcn_sched_barrier(0)
    Unit cur, nxt; int ui = 0;
    if (!S.next(0, cur)) return;
    f32x4 acc[2][2][4][2];
#pragma unroll
    for (int a = 0; a < 2; ++a)
#pragma unroll
        for (int b = 0; b < 2; ++b)
#pragma unroll
            for (int m = 0; m < 4; ++m)
#pragma unroll
                for (int n = 0; n < 2; ++n) acc[a][b][m][n] = (f32x4){0.f, 0.f, 0.f, 0.f};
    bf16x8 At[4][2], B0[2][2], B1[2][2];
    const char* cA = (const char*)g.A + (size_t)cur.pm * tstep; const char* cB = (const char*)g.Bt + (size_t)cur.pn * tstep;
    S.a_ready(cur);
    if constexpr (SP2) {
        PG8_STAGE(PG8_SB(0, 0), cB, voffB); PG8_STAGE(PG8_SB(0, 1), cB + hstep, voffB); PG8_STAGE(PG8_SA(0, 0), cA, voffA); PG8_STAGE(PG8_SA(0, 1), cA + hstep, voffA);
        if (wr == 1) PG8_BAR;
        PG8_WAIT_V(2); PG8_BAR;
        PG8_STAGE(PG8_SB(1, 0), cB + kstep, voffB); PG8_STAGE(PG8_SA(1, 0), cA + kstep, voffA); PG8_STAGE(PG8_SB(1, 1), cB + hstep + kstep, voffB);
        PG8_WAIT_V(6); PG8_BAR;
    } else {
        PG8_STAGE(PG8_SB(0, 0), cB, voffB); PG8_STAGE(PG8_SA(0, 0), cA, voffA); PG8_STAGE(PG8_SB(0, 1), cB + hstep, voffB); PG8_STAGE(PG8_SA(0, 1), cA + hstep, voffA);
        if (wr == 1) PG8_BAR;
        PG8_WAIT_V(4); PG8_BAR;
        PG8_STAGE(PG8_SB(1, 0), cB + kstep, voffB); PG8_STAGE(PG8_SA(1, 0), cA + kstep, voffA); PG8_STAGE(PG8_SB(1, 1), cB + hstep + kstep, voffB);
        PG8_WAIT_V(6); PG8_BAR;
    }
    for (;;) {
        const bool has_next = S.next(ui + 1, nxt);
        const char* nA = has_next ? (const char*)g.A + (size_t)nxt.pm * tstep : cA; const char* nB = has_next ? (const char*)g.Bt + (size_t)nxt.pn * tstep : cB;
        for (int t = 0; t < nt; t += 2) {
            const bool last = (t == nt - 2);
            const char* a1 = cA + (size_t)(t + 1) * kstep;
            const char* a2 = last ? nA : cA + (size_t)(t + 2) * kstep; const char* b2 = last ? nB : cB + (size_t)(t + 2) * kstep;
            const char* a3 = a2 + kstep; const char* b3 = b2 + kstep;
            if (last && has_next) S.a_ready(nxt);
            if constexpr (SP2) {
            PG8_LDB(B0, 0, 0); PG8_LDB(B1, 0, 1); PG8_SCHED; PG8_LDA(At, 0, 0); PG8_STAGE(PG8_SA(1, 1), a1 + hstep, voffA);
            PG8_WAIT_V(8); PG8_WAIT_L(0); PG8_BAR; PG8_MMA(0, 0, At, B0); PG8_MMA(0, 1, At, B1); PG8_BAR; PG8_SCHED;
            PG8_LDA(At, 0, 1); PG8_STAGE(PG8_SB(0, 0), b2, voffB); PG8_STAGE(PG8_SB(0, 1), b2 + hstep, voffB); PG8_STAGE(PG8_SA(0, 0), a2, voffA);
            PG8_WAIT_V(8); PG8_WAIT_L(0); PG8_BAR; PG8_MMA(1, 0, At, B0); PG8_MMA(1, 1, At, B1); PG8_BAR; PG8_SCHED;
            PG8_LDB(B0, 1, 0); PG8_LDB(B1, 1, 1); PG8_SCHED; PG8_LDA(At, 1, 0); PG8_STAGE(PG8_SA(0, 1), a2 + hstep, voffA);
            PG8_WAIT_V(8); PG8_WAIT_L(0); PG8_BAR; PG8_MMA(0, 0, At, B0); PG8_MMA(0, 1, At, B1); PG8_BAR; PG8_SCHED;
            PG8_LDA(At, 1, 1); PG8_STAGE(PG8_SB(1, 0), b3, voffB); PG8_STAGE(PG8_SB(1, 1), b3 + hstep, voffB); PG8_STAGE(PG8_SA(1, 0), a3, voffA);
            PG8_WAIT_V(8); PG8_WAIT_L(0); PG8_BAR; PG8_MMA(1, 0, At, B0); PG8_MMA(1, 1, At, B1); PG8_BAR; PG8_SCHED;
            } else {
            PG8_LDB(B0, 0, 0); PG8_SCHED; PG8_LDA(At, 0, 0); PG8_STAGE(PG8_SA(1, 1), a1 + hstep, voffA);
            PG8_WAIT_L(8); PG8_BAR; PG8_WAIT_L(0); PG8_MMA(0, 0, At, B0); PG8_BAR; PG8_SCHED;
            PG8_LDB(B1, 0, 1); PG8_STAGE(PG8_SB(0, 0), b2, voffB);
            PG8_BAR; PG8_WAIT_L(0); PG8_MMA(0, 1, At, B1); PG8_BAR;
            PG8_LDA(At, 0, 1); PG8_STAGE(PG8_SA(0, 0), a2, voffA);
            PG8_BAR; PG8_WAIT_L(0); PG8_MMA(1, 0, At, B0); PG8_BAR; PG8_SCHED;
            PG8_STAGE(PG8_SB(0, 1), b2 + hstep, voffB);
            PG8_WAIT_V(6); PG8_BAR; PG8_MMA(1, 1, At, B1); PG8_BAR;
            PG8_LDB(B0, 1, 0); PG8_SCHED; PG8_LDA(At, 1, 0); PG8_STAGE(PG8_SA(0, 1), a2 + hstep, voffA);
            PG8_WAIT_L(8); PG8_BAR; PG8_WAIT_L(0); PG8_MMA(0, 0, At, B0); PG8_BAR; PG8_SCHED;
            PG8_LDB(B1, 1, 1); PG8_STAGE(PG8_SB(1, 0), b3, voffB);
            PG8_BAR; PG8_WAIT_L(0); PG8_MMA(0, 1, At, B1); PG8_BAR;
            PG8_LDA(At, 1, 1); PG8_STAGE(PG8_SA(1, 0), a3, voffA);
            PG8_BAR; PG8_WAIT_L(0); PG8_MMA(1, 0, At, B0); PG8_BAR; PG8_SCHED;
            PG8_STAGE(PG8_SB(1, 1), b3 + hstep, voffB);
            PG8_WAIT_V(6); PG8_BAR; PG8_MMA(1, 1, At, B1); PG8_BAR;
            }
        }
        if constexpr (ALIGN_EPI) { if (wr == 0) PG8_BAR; }
        if constexpr (!Epi::AFTER_DRAIN) { E(acc, cur, wr, wc, fr, fq); S.done(cur); }
        if (!has_next) break;
#pragma unroll
        for (int a = 0; a < 2; ++a)
#pragma unroll
            for (int b = 0; b < 2; ++b)
#pragma unroll
                for (int m = 0; m < 4; ++m)
#pragma unroll
                    for (int n = 0; n < 2; ++n) acc[a][b][m][n] = (f32x4){0.f, 0.f, 0.f, 0.f};
        cur = nxt; cA = nA; cB = nB; ++ui;
        if constexpr (ALIGN_EPI) { if (wr == 1) PG8_BAR; }
    }
    PG8_WAIT_V(0);
    if constexpr (!ALIGN_EPI) { if (wr == 0) PG8_BAR; }
    PG8_BAR;
    if constexpr (Epi::AFTER_DRAIN) { E.fused(acc, cur, wr, wc, fr, fq, lds, wid, lane); S.done(cur); }
#undef PG8_SA
#undef PG8_SB
#undef PG8_STAGE
#undef PG8_LDA
#undef PG8_LDB
#undef PG8_MMA
#undef PG8_WAIT_V
#undef PG8_WAIT_L
#undef PG8_BAR
#undef PG8_SCHED
}
}
#define XB_TMO      128
#define XB_XCNT(j)  (256  + 64 * (j))
#define XB_XSUB(j)  (1280 + 64 * (j))
#define XB_XGEN(j)  (2304 + 64 * (j))
#define XB_TOP      3328
#define XB_TOPGEN   3392
#define XCD_BAR_WORDS 3456
#define XB_SPIN_CAP (1u << 18)
#define LAS __attribute__((address_space(3)))

__device__ __forceinline__ unsigned xb_ld(unsigned* p)              { return __hip_atomic_load(p, __ATOMIC_RELAXED, __HIP_MEMORY_SCOPE_AGENT); }
__device__ __forceinline__ unsigned xb_add(unsigned* p, unsigned v) { return __hip_atomic_fetch_add(p, v, __ATOMIC_RELAXED, __HIP_MEMORY_SCOPE_AGENT); }
__device__ __forceinline__ unsigned xb_xcc_id() { return (unsigned)__builtin_amdgcn_s_getreg((3 << 11) | 20) & 0xFu; }
#define XB_SPIN(cond, bar) do { unsigned _sp = 0; while (cond) { __builtin_amdgcn_s_sleep(1); \
    if ((++_sp & 255u) == 0u) { if (xb_ld(&(bar)[XB_TMO])) break; if (_sp > XB_SPIN_CAP) { atomicAdd(&(bar)[XB_TMO], 1u); break; } } } } while (0)

struct XcdBarrier {
    unsigned* bar; unsigned x;
    volatile LAS unsigned* st;
};

__device__ __forceinline__ XcdBarrier xcd_barrier_post(unsigned* bar, volatile LAS unsigned* st) {
    XcdBarrier b; b.bar = bar; b.x = xb_xcc_id(); b.st = st;
    if (threadIdx.x == 0) (void)xb_add(&bar[XB_XCNT(b.x)], 1u);
    return b;
}
__device__ __forceinline__ void xcd_barrier_complete(unsigned* bar, unsigned x, unsigned& nloc, unsigned& nx) {
    const unsigned G = gridDim.x * gridDim.y * gridDim.z;
    unsigned sum, cnt, mine, sp = 0u;
    for (;;) {
        sum = 0u; cnt = 0u; mine = 0u;
#pragma unroll
        for (unsigned j = 0; j < 16; ++j) { const unsigned c = xb_ld(&bar[XB_XCNT(j)]); sum += c; cnt += (c > 0u) ? 1u : 0u; mine = (j == x) ? c : mine; }
        if (sum == G) break;
        __builtin_amdgcn_s_sleep(1);
        if ((++sp & 255u) == 0u) { if (xb_ld(&bar[XB_TMO])) break; if (sp > XB_SPIN_CAP) { atomicAdd(&bar[XB_TMO], 1u); break; } }
    }
    nloc = mine > 0u ? mine : 1u; nx = cnt > 0u ? cnt : 1u;
}

__device__ __forceinline__ void xcd_barrier(const XcdBarrier& b) {
    asm volatile("s_waitcnt vmcnt(0)" ::: "memory");
    __syncthreads();
    if (threadIdx.x == 0) {
        unsigned* bar = b.bar;
        __builtin_amdgcn_s_waitcnt(0);
        unsigned nloc = b.st[0], nx = b.st[1];
        if (nloc == 0u) { xcd_barrier_complete(bar, b.x, nloc, nx); b.st[0] = nloc; b.st[1] = nx; }
        const unsigned old = xb_add(&bar[XB_XSUB(b.x)], 1u);
        const unsigned gen = old / nloc;
        if (old + 1u == (gen + 1u) * nloc) {
            __builtin_amdgcn_fence(__ATOMIC_RELEASE, "agent");
            asm volatile("s_waitcnt vmcnt(0)" ::: "memory");
            const unsigned og = xb_add(&bar[XB_TOP], 1u);
            const unsigned tg = og / nx;
            if (og + 1u == (tg + 1u) * nx) xb_add(&bar[XB_TOPGEN], 1u);
            else XB_SPIN(xb_ld(&bar[XB_TOPGEN]) == tg, bar);
            __builtin_amdgcn_fence(__ATOMIC_ACQUIRE, "agent");
            xb_add(&bar[XB_XGEN(b.x)], 1u);
            asm volatile("s_waitcnt vmcnt(0)" ::: "memory");
        } else {
            XB_SPIN(xb_ld(&bar[XB_XGEN(b.x)]) == gen, bar);
            __builtin_amdgcn_fence(__ATOMIC_ACQUIRE, "agent");
            asm volatile("s_waitcnt vmcnt(0)" ::: "memory");
        }
    }
    __syncthreads();
}

namespace cg = cooperative_groups;
namespace mk {
using pg8::bf16_t; using pg8::bf16x8; using pg8::f32x4; using pg8::u32x4; using pg8::Unit; using pg8::Gemm;
typedef float f32x16 __attribute__((ext_vector_type(16)));
typedef float f32x2 __attribute__((ext_vector_type(2)));
typedef unsigned u32x2 __attribute__((ext_vector_type(2)));
typedef __bf16 bf16x2_t __attribute__((ext_vector_type(2)));

constexpr int D = 1024, NB = 8, S = 4096, M = NB * S, NT = 512;
constexpr float EPS = 1e-6f, LOG2E = 1.4426950408889634f, QSCALE = 0.125f * 1.4426950408889634f;
constexpr size_t MiB = 1ull << 20;
constexpr size_t WS_MOD = 0;
constexpr size_t WS_BAR = 200704;
constexpr size_t WS_W0A = 256 * 1024;
constexpr size_t WS_WV  = WS_W0A + 10 * MiB;
constexpr size_t WS_WO0 = WS_WV + 2 * MiB;
constexpr size_t WS_WP  = WS_WO0 + 4 * MiB;
constexpr size_t WS_W1  = WS_WP + MiB / 2;
constexpr size_t WS_WO1 = WS_W1 + 16 * MiB;
constexpr size_t WS_H   = WS_WO1 + 4 * MiB;
constexpr size_t WS_BIG = WS_H + 64 * MiB;
constexpr size_t WS_U = WS_BIG, WS_Q = WS_BIG + 64 * MiB, WS_K = WS_BIG + 128 * MiB, WS_VT = WS_BIG + 192 * MiB, WS_G = WS_BIG + 256 * MiB;
constexpr size_t WS_UP = WS_BIG, WS_G1 = WS_BIG + 128 * MiB;
constexpr size_t WS_END = WS_BIG + 384 * MiB;

struct Args { const float* in[14]; float* out; unsigned char* ws; int ph_lo, ph_hi; };

#define MK_DI __device__ __forceinline__
MK_DI unsigned pk(float lo, float hi) { f32x2 v = {lo, hi}; return __builtin_bit_cast(unsigned, __builtin_convertvector(v, bf16x2_t)); }
MK_DI float bflo(unsigned w) { return __uint_as_float(w << 16); }
MK_DI float bfhi(unsigned w) { return __uint_as_float(w & 0xffff0000u); }
MK_DI float silu_f(float v) { return v * __builtin_amdgcn_rcpf(1.0f + __builtin_amdgcn_exp2f(-v * LOG2E)); }
MK_DI void unpack8(const u32x4 w, float (&f)[8]) { f[0] = bflo(w.x); f[1] = bfhi(w.x); f[2] = bflo(w.y); f[3] = bfhi(w.y); f[4] = bflo(w.z); f[5] = bfhi(w.z); f[6] = bflo(w.w); f[7] = bfhi(w.w); }
MK_DI u32x4 pack8(const float (&f)[8]) { u32x4 w; w.x = pk(f[0], f[1]); w.y = pk(f[2], f[3]); w.z = pk(f[4], f[5]); w.w = pk(f[6], f[7]); return w; }

MK_DI void p0_adaln(const float* c, const float* ada_w, const float* ada_b, float* mod, float* sm) {
    const int tid = threadIdx.x;
    for (int blk = blockIdx.x; blk < 192; blk += gridDim.x) {
        for (int i = tid; i < 8192; i += NT) sm[i] = silu_f(c[i]);
        __syncthreads();
        const int col = tid & 31, ks = tid >> 5;
        const int gcn = blk * 32 + col, l = gcn / 3072, n = gcn % 3072;
        float acc[8];
#pragma unroll
        for (int b = 0; b < 8; ++b) acc[b] = 0.f;
        const float* w = ada_w + (size_t)l * 1024 * 3072 + n;
        for (int kk0 = 0; kk0 < 64; kk0 += 16) {
            float wv[16];
#pragma unroll
            for (int u = 0; u < 16; ++u) wv[u] = w[(size_t)(ks + 16 * (kk0 + u)) * 3072];
#pragma unroll
            for (int u = 0; u < 16; ++u) {
                const int k = ks + 16 * (kk0 + u);
#pragma unroll
                for (int b = 0; b < 8; ++b) acc[b] += sm[b * 1024 + k] * wv[u];
            }
        }
        float* red = sm + 8192;
#pragma unroll
        for (int b = 0; b < 8; ++b) red[(ks * 32 + col) * 8 + b] = acc[b];
        __syncthreads();
        if (tid < 256) {
            const int cc = tid & 31, b = tid >> 5; float s = 0.f;
            for (int k2 = 0; k2 < 16; ++k2) s += red[(k2 * 32 + cc) * 8 + b];
            const int g2 = blk * 32 + cc, l2 = g2 / 3072, n2 = g2 % 3072;
            mod[(l2 * 8 + b) * 3072 + n2] = s + ada_b[l2 * 3072 + n2];
        }
        __syncthreads();
    }
}

MK_DI void p0_transpose(const Args& a, float* sm) {
    const int tid = threadIdx.x;
    unsigned char* ws = a.ws;
    for (int t = blockIdx.x; t < 1168; t += gridDim.x) {
        const float* src; bf16_t* dst; int ld, K, tn, tk, mode;
        if (t < 320)       { src = a.in[5];  ld = 6144; K = 1024; tn = t >> 2; tk = t & 3; mode = 0; dst = (bf16_t*)(ws + WS_W0A); }
        else if (t < 384)  { const int u = t - 320; src = a.in[5] + 3072; ld = 6144; K = 1024; tn = u >> 2; tk = u & 3; mode = 1; dst = (bf16_t*)(ws + WS_WV); }
        else if (t < 512)  { const int u = t - 384; src = a.in[8];  ld = 1024; K = 2048; tn = u >> 3; tk = u & 7; mode = 1; dst = (bf16_t*)(ws + WS_WO0); }
        else if (t < 528)  { const int u = t - 512, g = u >> 2; src = a.in[6] + g * 65536; ld = 256; K = 256; tn = u & 3; tk = 0; mode = 1; dst = (bf16_t*)(ws + WS_WP) + g * 65536; }
        else if (t < 1040) { const int u = t - 528; src = a.in[9];  ld = 8192; K = 1024; tn = u >> 2; tk = u & 3; mode = 2; dst = (bf16_t*)(ws + WS_W1); }
        else               { const int u = t - 1040; src = a.in[12]; ld = 1024; K = 2048; tn = u >> 3; tk = u & 7; mode = 1; dst = (bf16_t*)(ws + WS_WO1); }
        const int nn = tid & 63, n1 = tn * 64 + nn, kr = tid >> 6;
        int col;
        if (mode == 0) col = n1 < 3072 ? n1 : n1 + 1024;
        else if (mode == 1) col = n1;
        else { const int pn = n1 >> 8, bj = (n1 >> 7) & 1, wc = (n1 >> 5) & 3, n = (n1 >> 4) & 1, fq = (n1 >> 2) & 3, j = n1 & 3; col = (2 * bj + n) * 2048 + 64 * pn + 16 * wc + 4 * fq + j; }
        const float* sp = src + (size_t)(tk * 256 + kr) * ld + col;
        float v[32];
#pragma unroll
        for (int e = 0; e < 32; ++e) v[e] = sp[(size_t)(8 * e) * ld];
#pragma unroll
        for (int e = 0; e < 32; ++e) sm[nn * 257 + kr + 8 * e] = v[e];
        __syncthreads();
#pragma unroll
        for (int i = 0; i < 4; ++i) {
            const int p = tid + 512 * i, wn = p & 63, kc = (p >> 6) * 8;
            float f[8];
#pragma unroll
            for (int j = 0; j < 8; ++j) f[j] = sm[wn * 257 + kc + j];
            *(u32x4*)(dst + (size_t)(tn * 64 + wn) * K + tk * 256 + kc) = pack8(f);
        }
        __syncthreads();
    }
}

MK_DI float wave_sum(float v) {
#pragma unroll
    for (int off = 32; off >= 1; off >>= 1) v += __shfl_xor(v, off);
    return v;
}
MK_DI void p_norm_mod(const float* xin, const float* g, const float* modl, bf16_t* H) {
    const int tid = threadIdx.x, lane = tid & 63, wid = tid >> 6, stride = gridDim.x * 8;
    for (int rowa = blockIdx.x * 8 + wid; rowa < M; rowa += 2 * stride) {
        const bool ok1 = rowa + stride < M;
        int rows[2]; rows[0] = rowa; rows[1] = ok1 ? rowa + stride : rowa;
        f32x4 v[2][4];
#pragma unroll
        for (int q = 0; q < 2; ++q)
#pragma unroll
            for (int j = 0; j < 4; ++j) v[q][j] = *(const f32x4*)(xin + (size_t)rows[q] * D + 4 * lane + 256 * j);
#pragma unroll
        for (int q = 0; q < 2; ++q) {
            float ss = 0.f;
#pragma unroll
            for (int j = 0; j < 4; ++j) ss += v[q][j].x * v[q][j].x + v[q][j].y * v[q][j].y + v[q][j].z * v[q][j].z + v[q][j].w * v[q][j].w;
            ss = wave_sum(ss);
            const float rstd = rsqrtf(ss * (1.0f / 1024.0f) + EPS);
            const float* mb = modl + (rows[q] >> 12) * 3072 + 4 * lane;
            if (q == 0 || ok1) {
#pragma unroll
                for (int j = 0; j < 4; ++j) {
                    const f32x4 gv = *(const f32x4*)(g + 4 * lane + 256 * j), sh = *(const f32x4*)(mb + 256 * j), sc = *(const f32x4*)(mb + 1024 + 256 * j);
                    const f32x4 hh = (v[q][j] * rstd) * gv * (sc + 1.0f) + sh;
                    u32x2 w; w.x = pk(hh.x, hh.y); w.y = pk(hh.z, hh.w);
                    *(u32x2*)(H + (size_t)rows[q] * D + 4 * lane + 256 * j) = w;
                }
            }
        }
    }
}
MK_DI void p_final_norm(float* xo, const float* g) {
    const int tid = threadIdx.x, lane = tid & 63, wid = tid >> 6, stride = gridDim.x * 8;
    for (int rowa = blockIdx.x * 8 + wid; rowa < M; rowa += 2 * stride) {
        const bool ok1 = rowa + stride < M;
        int rows[2]; rows[0] = rowa; rows[1] = ok1 ? rowa + stride : rowa;
        f32x4 v[2][4];
#pragma unroll
        for (int q = 0; q < 2; ++q)
#pragma unroll
            for (int j = 0; j < 4; ++j) v[q][j] = *(const f32x4*)(xo + (size_t)rows[q] * D + 4 * lane + 256 * j);
#pragma unroll
        for (int q = 0; q < 2; ++q) {
            float ss = 0.f;
#pragma unroll
            for (int j = 0; j < 4; ++j) ss += v[q][j].x * v[q][j].x + v[q][j].y * v[q][j].y + v[q][j].z * v[q][j].z + v[q][j].w * v[q][j].w;
            ss = wave_sum(ss);
            const float rstd = rsqrtf(ss * (1.0f / 1024.0f) + EPS);
            if (q == 0 || ok1) {
#pragma unroll
                for (int j = 0; j < 4; ++j) { const f32x4 gv = *(const f32x4*)(g + 4 * lane + 256 * j); *(f32x4*)(xo + (size_t)rows[q] * D + 4 * lane + 256 * j) = (v[q][j] * rstd) * gv; }
            }
        }
    }
}

struct EpiProj0 {
    static constexpr bool PERM = true, AFTER_DRAIN = false;
    bf16_t *U, *Q, *Kh, *G;
    MK_DI void operator()(const f32x4 (&acc)[2][2][4][2], const Unit& u, int wr, int wc, int fr, int fq) const {
        const int reg = u.pn >> 2, row0 = u.pm * 256 + wr * 64 + fr, cb = u.pn * 256 + wc * 32 + 8 * fq;
#pragma unroll
        for (int ai = 0; ai < 2; ++ai)
#pragma unroll
            for (int m = 0; m < 4; ++m) {
                const int row = row0 + ai * 128 + m * 16;
#pragma unroll
                for (int bj = 0; bj < 2; ++bj) {
                    const int c = cb + bj * 128; f32x4 v0 = acc[ai][bj][m][0], v1 = acc[ai][bj][m][1]; bf16_t* ptr;
                    if (reg == 0) ptr = U + (size_t)row * 1024 + c;
                    else if (reg == 1) { v0 *= QSCALE; v1 *= QSCALE; ptr = Q + (size_t)row * 1024 + (c - 1024); }
                    else if (reg == 2) { const int cc = c - 2048; ptr = Kh + ((size_t)((row >> 12) * 16 + (cc >> 6)) * 4096 + (row & 4095)) * 64 + (cc & 63); }
                    else { v0.x = silu_f(v0.x); v0.y = silu_f(v0.y); v0.z = silu_f(v0.z); v0.w = silu_f(v0.w); v1.x = silu_f(v1.x); v1.y = silu_f(v1.y); v1.z = silu_f(v1.z); v1.w = silu_f(v1.w);
                           ptr = G + (size_t)row * 2048 + (c - 3072); }
                    u32x4 w; w.x = pk(v0.x, v0.y); w.y = pk(v0.z, v0.w); w.z = pk(v1.x, v1.y); w.w = pk(v1.z, v1.w);
                    *(u32x4*)ptr = w;
                }
            }
    }
};
struct EpiVt {
    static constexpr bool PERM = true, AFTER_DRAIN = false;
    bf16_t* Vt;
    MK_DI void operator()(const f32x4 (&acc)[2][2][4][2], const Unit& u, int wr, int wc, int fr, int fq) const {
        const int row0 = u.pm * 256 + wr * 64 + fr, cb = u.pn * 256 + wc * 32 + 8 * fq;
#pragma unroll
        for (int ai = 0; ai < 2; ++ai)
#pragma unroll
            for (int m = 0; m < 4; ++m) {
                const int row = row0 + ai * 128 + m * 16;
#pragma unroll
                for (int bj = 0; bj < 2; ++bj) {
                    const f32x4 v0 = acc[ai][bj][m][0], v1 = acc[ai][bj][m][1];
                    u32x4 w; w.x = pk(v0.x, v0.y); w.y = pk(v0.z, v0.w); w.z = pk(v1.x, v1.y); w.w = pk(v1.z, v1.w);
                    *(u32x4*)(Vt + (size_t)row * 32768 + cb + bj * 128) = w;
                }
            }
    }
};
struct EpiRes {
    static constexpr bool PERM = false, AFTER_DRAIN = false;
    const float* res; float* out; const float* gate;
    MK_DI void operator()(const f32x4 (&acc)[2][2][4][2], const Unit& u, int wr, int wc, int fr, int fq) const {
        const int row0 = u.pm * 256 + wr * 64 + fr, col0 = u.pn * 256 + wc * 32 + 4 * fq, b = (u.pm * 256) >> 12;
        f32x4 gv[2][2];
#pragma unroll
        for (int bj = 0; bj < 2; ++bj)
#pragma unroll
            for (int n = 0; n < 2; ++n) gv[bj][n] = *(const f32x4*)(gate + b * 3072 + col0 + bj * 128 + n * 16) + 1.0f;
#pragma unroll
        for (int ai = 0; ai < 2; ++ai)
#pragma unroll
            for (int m = 0; m < 4; ++m) {
                const size_t off = (size_t)(row0 + ai * 128 + m * 16) * 1024 + col0;
#pragma unroll
                for (int bj = 0; bj < 2; ++bj)
#pragma unroll
                    for (int n = 0; n < 2; ++n) { const size_t o = off + bj * 128 + n * 16; const f32x4 r = *(const f32x4*)(res + o); *(f32x4*)(out + o) = r + gv[bj][n] * acc[ai][bj][m][n]; }
            }
    }
};
struct EpiGate {
    static constexpr bool PERM = false, AFTER_DRAIN = false;
    bf16_t *UP, *G1;
    MK_DI void operator()(const f32x4 (&acc)[2][2][4][2], const Unit& u, int wr, int wc, int fr, int fq) const {
        const int row0 = u.pm * 256 + wr * 64 + fr, ch0 = u.pn * 64 + wc * 16 + 4 * fq;
#pragma unroll
        for (int ai = 0; ai < 2; ++ai)
#pragma unroll
            for (int m = 0; m < 4; ++m) {
                const size_t off = (size_t)(row0 + ai * 128 + m * 16) * 2048 + ch0;
                const f32x4 gb = acc[ai][0][m][0], gc = acc[ai][0][m][1], uu = acc[ai][1][m][0], gt = acc[ai][1][m][1];
                const f32x4 up = gc * uu;
                f32x4 gg; gg.x = gb.x * silu_f(gt.x); gg.y = gb.y * silu_f(gt.y); gg.z = gb.z * silu_f(gt.z); gg.w = gb.w * silu_f(gt.w);
                u32x2 w0, w1; w0.x = pk(up.x, up.y); w0.y = pk(up.z, up.w); w1.x = pk(gg.x, gg.y); w1.y = pk(gg.z, gg.w);
                *(u32x2*)(UP + off) = w0; *(u32x2*)(G1 + off) = w1;
            }
    }
};
struct EpiGateConv {
    static constexpr bool PERM = false, AFTER_DRAIN = false;
    bf16_t* Y1; float* US; float* GS; const float* cw; const float* cbias;
    MK_DI void operator()(const f32x4 (&acc)[2][2][4][2], const Unit& u, int wr, int wc, int fr, int fq) const {
        const int lane = fq * 16 + fr, row0 = u.pm * 256 + wr * 64 + fr, ch0 = u.pn * 64 + wc * 16 + 4 * fq;
        const f32x4 w0 = *(const f32x4*)(cw + ch0), w1 = *(const f32x4*)(cw + 2048 + ch0), w2 = *(const f32x4*)(cw + 4096 + ch0), cb = *(const f32x4*)(cbias + ch0);
        const int src1 = (lane & 48) | ((fr + 15) & 15), src2 = (lane & 48) | ((fr + 14) & 15);
#pragma unroll
        for (int ai = 0; ai < 2; ++ai) {
            const int grp = u.pm * 4 + ai * 2 + wr;
            f32x4 p1 = {0.f, 0.f, 0.f, 0.f}, p2 = {0.f, 0.f, 0.f, 0.f};
#pragma unroll
            for (int m = 0; m < 4; ++m) {
                const f32x4 gb = acc[ai][0][m][0], gc = acc[ai][0][m][1], uu = acc[ai][1][m][0], gt = acc[ai][1][m][1];
                const f32x4 up = gc * uu;
                f32x4 gg; gg.x = gb.x * silu_f(gt.x); gg.y = gb.y * silu_f(gt.y); gg.z = gb.z * silu_f(gt.z); gg.w = gb.w * silu_f(gt.w);
                f32x4 r1, r2;
                r1.x = __shfl(up.x, src1); r1.y = __shfl(up.y, src1); r1.z = __shfl(up.z, src1); r1.w = __shfl(up.w, src1);
                r2.x = __shfl(up.x, src2); r2.y = __shfl(up.y, src2); r2.z = __shfl(up.z, src2); r2.w = __shfl(up.w, src2);
                f32x4 um1 = r1, um2 = r2;
                if (m > 0) { if (fr == 0) um1 = p1; if (fr < 2) um2 = p2; }
                p1 = r1; p2 = r2;
                const f32x4 y = gg * (cb + w0 * um2 + w1 * um1 + w2 * up);
                u32x2 w; w.x = pk(y.x, y.y); w.y = pk(y.z, y.w);
                *(u32x2*)(Y1 + (size_t)(row0 + ai * 128 + m * 16) * 2048 + ch0) = w;
                if (m == 0 && fr < 2) { *(f32x4*)(US + (size_t)(grp * 4 + fr) * 2048 + ch0) = up; *(f32x4*)(GS + (size_t)(grp * 2 + fr) * 2048 + ch0) = gg; }
                if (m == 3 && fr >= 14) *(f32x4*)(US + (size_t)(grp * 4 + fr - 12) * 2048 + ch0) = up;
            }
        }
    }
};
struct EpiPool {
    static constexpr bool PERM = true, AFTER_DRAIN = false;
    bf16_t* G; const float* pscale;
    MK_DI void operator()(const f32x4 (&acc)[2][2][4][2], const Unit& u, int wr, int wc, int fr, int fq) const {
        const int row0 = (u.pm & 127) * 256 + wr * 64 + fr, cb = u.pn * 256 + wc * 32 + 8 * fq;
        f32x4 ps[2][2];
#pragma unroll
        for (int bj = 0; bj < 2; ++bj) { ps[bj][0] = *(const f32x4*)(pscale + cb + bj * 128); ps[bj][1] = *(const f32x4*)(pscale + cb + bj * 128 + 4); }
#pragma unroll
        for (int ai = 0; ai < 2; ++ai)
#pragma unroll
            for (int m = 0; m < 4; ++m) {
                const int row = row0 + ai * 128 + m * 16;
#pragma unroll
                for (int bj = 0; bj < 2; ++bj) {
                    bf16_t* ptr = G + (size_t)row * 2048 + cb + bj * 128;
                    const u32x4 gw = *(const u32x4*)ptr;
                    const f32x4 v0 = acc[ai][bj][m][0] * ps[bj][0], v1 = acc[ai][bj][m][1] * ps[bj][1];
                    u32x4 w; w.x = pk(v0.x * bflo(gw.x), v0.y * bfhi(gw.x)); w.y = pk(v0.z * bflo(gw.y), v0.w * bfhi(gw.y));
                    w.z = pk(v1.x * bflo(gw.z), v1.y * bfhi(gw.z)); w.w = pk(v1.z * bflo(gw.w), v1.w * bfhi(gw.w));
                    *(u32x4*)ptr = w;
                }
            }
    }
};
struct PoolSched {
    int G, c;
    __device__ bool next(int i, Unit& u) const { const int L = i * G + c; if (L >= 512) return false; u.pm = L; u.pn = L >> 7; return true; }
    MK_DI void a_ready(const Unit&) const {}
    MK_DI void done(const Unit&) const {}
};

MK_DI void p_pool_prep(const bf16_t* U, bf16_t* P) {
    for (int item = blockIdx.x * NT + threadIdx.x; item < 1024 * 128; item += gridDim.x * NT) {
        const int chunk = item & 127, tb = item >> 7, g = chunk >> 5, w = 2 << g, t0 = tb * 32, pos0 = t0 & 4095;
        const bf16_t* up = U + (size_t)t0 * 1024 + chunk * 8;
        bf16_t* pp = P + ((size_t)g * 32768 + t0) * 256 + (chunk & 31) * 8;
        float s[8];
#pragma unroll
        for (int i = 0; i < 8; ++i) s[i] = 0.f;
        for (int i = 1; i < w; ++i) if (pos0 - i >= 0) { float f[8]; unpack8(*(const u32x4*)(up - (ptrdiff_t)i * 1024), f);
#pragma unroll
            for (int e = 0; e < 8; ++e) s[e] += f[e]; }
        for (int tt = 0; tt < 32; ++tt) {
            float cur[8], p[8]; unpack8(*(const u32x4*)(up + (size_t)tt * 1024), cur);
            const int cnt = (pos0 + tt + 1) < w ? (pos0 + tt + 1) : w; const float inv = 1.0f / (float)cnt;
#pragma unroll
            for (int e = 0; e < 8; ++e) { s[e] += cur[e]; p[e] = s[e] * inv - cur[e]; }
            *(u32x4*)(pp + (size_t)tt * 256) = pack8(p);
            const int old = tt - (w - 1);
            if (pos0 + old >= 0) { float f[8]; unpack8(*(const u32x4*)(up + (ptrdiff_t)old * 1024), f);
#pragma unroll
                for (int e = 0; e < 8; ++e) s[e] -= f[e]; }
        }
    }
}

#define MK_MFMA32(a, b, c) __builtin_amdgcn_mfma_f32_32x32x16_bf16((a), (b), (c), 0, 0, 0)
MK_DI void p_attn(const bf16_t* Q, const bf16_t* Kh, const bf16_t* Vt, bf16_t* G) {
    const int tid = threadIdx.x, lane = tid & 63, wid = tid >> 6, r = lane & 31, h = lane >> 5;
    const int pr = (r & 0x13) | ((r & 4) << 1) | ((r & 8) >> 1);
    for (int unit = blockIdx.x * 8 + wid; unit < 16384; unit += gridDim.x * 8) {
        const int qb = unit & 127, head = (unit >> 7) & 15, b = unit >> 11, q0 = qb * 32;
        const bf16_t* qp = Q + (size_t)(b * 4096 + q0 + r) * 1024 + head * 64 + 8 * h;
        bf16x8 qf[4];
#pragma unroll
        for (int kk = 0; kk < 4; ++kk) qf[kk] = *(const bf16x8*)(qp + 16 * kk);
        const bf16_t* kbase = Kh + ((size_t)(b * 16 + head) * 4096 + pr) * 64 + 8 * h;
        const bf16_t* vbase = Vt + (size_t)(head * 64 + r) * 32768 + b * 4096 + 8 * h;
        f32x16 o0, o1;
#pragma unroll
        for (int i = 0; i < 16; ++i) { o0[i] = 0.f; o1[i] = 0.f; }
        float carry = 1.0f;
        bf16x8 kf[4], vf[4], kf1[4], vf1[4];
#pragma unroll
        for (int kk = 0; kk < 4; ++kk) kf[kk] = *(const bf16x8*)(kbase + (size_t)q0 * 64 + 16 * kk);
#pragma unroll
        for (int i = 0; i < 4; ++i) vf[i] = *(const bf16x8*)(vbase + (size_t)(i >> 1) * 32 * 32768 + q0 + 16 * (i & 1));
        { const int kl1 = q0 >= 32 ? q0 - 32 : 0;
#pragma unroll
          for (int kk = 0; kk < 4; ++kk) kf1[kk] = *(const bf16x8*)(kbase + (size_t)kl1 * 64 + 16 * kk);
#pragma unroll
          for (int i = 0; i < 4; ++i) vf1[i] = *(const bf16x8*)(vbase + (size_t)(i >> 1) * 32 * 32768 + kl1 + 16 * (i & 1)); }
        int k0 = q0;
        for (;;) {
            const int k1 = k0 - 32, k2 = k0 - 64, kl = k2 < 0 ? 0 : k2;
            bf16x8 kn[4], vn[4];
#pragma unroll
            for (int kk = 0; kk < 4; ++kk) kn[kk] = *(const bf16x8*)(kbase + (size_t)kl * 64 + 16 * kk);
#pragma unroll
            for (int i = 0; i < 4; ++i) vn[i] = *(const bf16x8*)(vbase + (size_t)(i >> 1) * 32 * 32768 + kl + 16 * (i & 1));
            f32x16 z;
#pragma unroll
            for (int i = 0; i < 16; ++i) z[i] = 0.f;
#pragma unroll
            for (int kk = 0; kk < 4; ++kk) z = MK_MFMA32(kf[kk], qf[kk], z);
            const bool diag = (k0 == q0);
            float ez[16], cf[16];
#pragma unroll
            for (int i = 0; i < 16; ++i) {
                const int krel = 16 * (i >> 3) + 8 * h + (i & 7);
                float zz = fminf(z[i], 100.0f);
                if (diag && krel >= r) zz = -__builtin_inff();
                ez[i] = __builtin_amdgcn_exp2f(zz);
                cf[i] = __builtin_amdgcn_rcpf(1.0f + ez[i]);
            }
#pragma unroll
            for (int i = 6; i >= 0; --i) { cf[i] *= cf[i + 1]; cf[i + 8] *= cf[i + 9]; }
            const float plo = cf[0], phi = cf[8];
            const float plo_p = __shfl_xor(plo, 32), phi_p = __shfl_xor(phi, 32);
            const float pre_hi = carry * (h == 0 ? phi_p : 1.0f);
            const float pre_lo = carry * (phi * phi_p) * (h == 0 ? plo_p : 1.0f);
            carry = carry * (plo * plo_p) * (phi * phi_p);
            float a[16];
#pragma unroll
            for (int i = 0; i < 8; ++i) { a[i] = (ez[i] * cf[i]) * pre_lo; a[i + 8] = (ez[i + 8] * cf[i + 8]) * pre_hi; }
            u32x4 w0, w1;
            w0.x = pk(a[0], a[1]); w0.y = pk(a[2], a[3]); w0.z = pk(a[4], a[5]); w0.w = pk(a[6], a[7]);
            w1.x = pk(a[8], a[9]); w1.y = pk(a[10], a[11]); w1.z = pk(a[12], a[13]); w1.w = pk(a[14], a[15]);
            const bf16x8 p0 = __builtin_bit_cast(bf16x8, w0), p1 = __builtin_bit_cast(bf16x8, w1);
            o0 = MK_MFMA32(vf[0], p0, o0); o0 = MK_MFMA32(vf[1], p1, o0);
            o1 = MK_MFMA32(vf[2], p0, o1); o1 = MK_MFMA32(vf[3], p1, o1);
            if (k1 < 0) break;
            if (__all(carry < 1e-37f)) break;
#pragma unroll
            for (int i = 0; i < 4; ++i) { kf[i] = kf1[i]; vf[i] = vf1[i]; kf1[i] = kn[i]; vf1[i] = vn[i]; }
            k0 = k1;
        }
        bf16_t* gp = G + (size_t)(b * 4096 + q0 + r) * 2048 + 1024 + head * 64 + 4 * h;
#pragma unroll
        for (int g4 = 0; g4 < 4; ++g4) {
            { u32x2* p = (u32x2*)(gp + 8 * g4); const u32x2 gw = *p; u32x2 w;
              w.x = pk(o0[4 * g4] * bflo(gw.x), o0[4 * g4 + 1] * bfhi(gw.x)); w.y = pk(o0[4 * g4 + 2] * bflo(gw.y), o0[4 * g4 + 3] * bfhi(gw.y)); *p = w; }
            { u32x2* p = (u32x2*)(gp + 32 + 8 * g4); const u32x2 gw = *p; u32x2 w;
              w.x = pk(o1[4 * g4] * bflo(gw.x), o1[4 * g4 + 1] * bfhi(gw.x)); w.y = pk(o1[4 * g4 + 2] * bflo(gw.y), o1[4 * g4 + 3] * bfhi(gw.y)); *p = w; }
        }
    }
}

MK_DI void p_conv(const bf16_t* UP, bf16_t* G1, const float* cw, const float* cbias) {
    for (int item = blockIdx.x * NT + threadIdx.x; item < 2048 * 256; item += gridDim.x * NT) {
        const int chunk = item & 255, tb = item >> 8, t0 = tb * 16, pos0 = t0 & 4095, c0 = chunk * 8;
        float w0[8], w1[8], w2[8], bb[8], um2[8], um1[8];
#pragma unroll
        for (int e = 0; e < 8; ++e) { w0[e] = cw[c0 + e]; w1[e] = cw[2048 + c0 + e]; w2[e] = cw[4096 + c0 + e]; bb[e] = cbias[c0 + e]; um2[e] = 0.f; um1[e] = 0.f; }
        const bf16_t* up = UP + (size_t)t0 * 2048 + c0; bf16_t* gp = G1 + (size_t)t0 * 2048 + c0;
        if (pos0 != 0) { unpack8(*(const u32x4*)(up - 4096), um2); unpack8(*(const u32x4*)(up - 2048), um1); }
        for (int tt = 0; tt < 16; ++tt) {
            float cur[8], gg[8], y[8];
            unpack8(*(const u32x4*)(up + (size_t)tt * 2048), cur); unpack8(*(const u32x4*)(gp + (size_t)tt * 2048), gg);
#pragma unroll
            for (int e = 0; e < 8; ++e) { y[e] = gg[e] * (bb[e] + w0[e] * um2[e] + w1[e] * um1[e] + w2[e] * cur[e]); um2[e] = um1[e]; um1[e] = cur[e]; }
            *(u32x4*)(gp + (size_t)tt * 2048) = pack8(y);
        }
    }
}

MK_DI void p_fixup(const float* US, const float* GS, const float* cw, const float* cbias, bf16_t* Y1) {
    for (int item = blockIdx.x * NT + threadIdx.x; item < 512 * 2 * 512; item += gridDim.x * NT) {
        const int c4 = (item & 511) * 4, i = (item >> 9) & 1, grp = item >> 10;
        const bool first = (grp & 63) == 0;
        const f32x4 zero = {0.f, 0.f, 0.f, 0.f};
        const f32x4 cur = *(const f32x4*)(US + (size_t)(grp * 4 + i) * 2048 + c4), gg = *(const f32x4*)(GS + (size_t)(grp * 2 + i) * 2048 + c4);
        f32x4 um1, um2;
        if (i == 0) { um1 = first ? zero : *(const f32x4*)(US + (size_t)((grp - 1) * 4 + 3) * 2048 + c4); um2 = first ? zero : *(const f32x4*)(US + (size_t)((grp - 1) * 4 + 2) * 2048 + c4); }
        else        { um1 = *(const f32x4*)(US + (size_t)(grp * 4) * 2048 + c4);                          um2 = first ? zero : *(const f32x4*)(US + (size_t)((grp - 1) * 4 + 3) * 2048 + c4); }
        const f32x4 w0 = *(const f32x4*)(cw + c4), w1 = *(const f32x4*)(cw + 2048 + c4), w2 = *(const f32x4*)(cw + 4096 + c4), cb = *(const f32x4*)(cbias + c4);
        const f32x4 y = gg * (cb + w0 * um2 + w1 * um1 + w2 * cur);
        u32x2 w; w.x = pk(y.x, y.y); w.y = pk(y.z, y.w);
        *(u32x2*)(Y1 + (size_t)(grp * 64 + i) * 2048 + c4) = w;
    }
}

template <class Epi> MK_DI void run_gemm(PG8_LAS unsigned char* lds, const bf16_t* A, const bf16_t* Bt, int Mr, int Nc, int K, const Epi& E) {
    Gemm g; g.A = A; g.Bt = Bt; g.M = Mr; g.N = Nc; g.K = K;
    pg8::StaticOrder so; so.init(Mr, Nc, (int)gridDim.x, (int)blockIdx.x);
    pg8::gemm_phase<Epi, pg8::StaticOrder, true, true>(lds, g, so, E);
}

__global__ void __launch_bounds__(512, 2) mk_fwd(Args a) {
    extern __shared__ __attribute__((aligned(16))) unsigned char smem[];
    cg::grid_group grid = cg::this_grid();
    PG8_LAS unsigned char* lds = (PG8_LAS unsigned char*)smem;
    float* smf = (float*)smem;
    unsigned char* ws = a.ws;
    const int lo = a.ph_lo, hi = a.ph_hi;
    float* mod = (float*)(ws + WS_MOD);
    bf16_t* H = (bf16_t*)(ws + WS_H);
    bf16_t *U = (bf16_t*)(ws + WS_U), *Q = (bf16_t*)(ws + WS_Q), *Kh = (bf16_t*)(ws + WS_K), *Vt = (bf16_t*)(ws + WS_VT), *G = (bf16_t*)(ws + WS_G);
    bf16_t *UP = (bf16_t*)(ws + WS_UP), *G1 = (bf16_t*)(ws + WS_G1);
#define MK_IN(k) (lo <= (k) && (k) < hi)
    volatile LAS unsigned* xst = (volatile LAS unsigned*)(lds + 131072);
    if (threadIdx.x < 4) xst[threadIdx.x] = 0u;
    __syncthreads();
    XcdBarrier xbar = xcd_barrier_post((unsigned*)(ws + WS_BAR), xst);
    if (lo < 0) grid.sync();
#define MK_SEAM(k) do { if (MK_IN(k) && MK_IN((k) + 1)) xcd_barrier(xbar); } while (0)
    if (MK_IN(0)) { p0_adaln(a.in[1], a.in[3], a.in[4], mod, smf); p0_transpose(a, smf); }
    MK_SEAM(0);
    if (MK_IN(1)) p_norm_mod(a.in[0], a.in[2], mod, H);
    MK_SEAM(1);
    if (MK_IN(2)) {
        EpiProj0 e0; e0.U = U; e0.Q = Q; e0.Kh = Kh; e0.G = G;
        run_gemm(lds, H, (const bf16_t*)(ws + WS_W0A), M, 5120, 1024, e0);
        EpiVt e1; e1.Vt = Vt;
        run_gemm(lds, (const bf16_t*)(ws + WS_WV), H, 1024, M, 1024, e1);
    }
    MK_SEAM(2);
    if (MK_IN(3)) { p_attn(Q, Kh, Vt, G); p_pool_prep(U, H); }
    MK_SEAM(3);
    if (MK_IN(4)) {
        EpiPool e; e.G = G; e.pscale = a.in[7];
        Gemm g; g.A = H; g.Bt = (const bf16_t*)(ws + WS_WP); g.M = 4 * M; g.N = 1024; g.K = 256;
        PoolSched ps; ps.G = (int)gridDim.x; ps.c = (int)blockIdx.x;
        pg8::gemm_phase<EpiPool, PoolSched, true, true>(lds, g, ps, e);
    }
    MK_SEAM(4);
    if (MK_IN(5)) { EpiRes e; e.res = a.in[0]; e.out = a.out; e.gate = mod + 2048; run_gemm(lds, G, (const bf16_t*)(ws + WS_WO0), M, 1024, 2048, e); }
    MK_SEAM(5);
    if (MK_IN(6)) p_norm_mod(a.out, a.in[2] + 1024, mod + 8 * 3072, H);
    MK_SEAM(6);
    float* US = (float*)(ws + WS_UP); float* GS = (float*)(ws + WS_UP + 16 * MiB);
    if (MK_IN(7)) { EpiGateConv e; e.Y1 = G1; e.US = US; e.GS = GS; e.cw = a.in[10]; e.cbias = a.in[11]; run_gemm(lds, H, (const bf16_t*)(ws + WS_W1), M, 8192, 1024, e); }
    MK_SEAM(7);
    if (MK_IN(8)) p_fixup(US, GS, a.in[10], a.in[11], G1);
    MK_SEAM(8);
    if (MK_IN(9)) { EpiRes e; e.res = a.out; e.out = a.out; e.gate = mod + 8 * 3072 + 2048; run_gemm(lds, G1, (const bf16_t*)(ws + WS_WO1), M, 1024, 2048, e); }
    MK_SEAM(9);
    if (MK_IN(10)) p_final_norm(a.out, a.in[13]);
}
}

#ifndef MK_ONE_LAUNCH
#define MK_ONE_LAUNCH 1
#endif
constexpr int MK_LDS_BYTES = 131072 + 16;
extern "C" void kernel_launch(void* const* d_in, const int* in_sizes, int n_in, void* d_out, int out_size, void* d_ws, size_t ws_size, hipStream_t stream) {
    static int grid = 0;
    if (grid == 0) {
        if (n_in != 14 || out_size != mk::M * mk::D || ws_size < mk::WS_END) { fprintf(stderr, "kernel_launch: unexpected shapes (n_in %d, out %d, ws %zu < %zu)\n", n_in, out_size, ws_size, (size_t)mk::WS_END); grid = -1; return; }
        int dev = 0, cus = 0, per_cu = 0;
        if (hipGetDevice(&dev) != hipSuccess || hipDeviceGetAttribute(&cus, hipDeviceAttributeMultiprocessorCount, dev) != hipSuccess) { grid = -1; return; }
        if (hipFuncSetAttribute((const void*)mk::mk_fwd, hipFuncAttributeMaxDynamicSharedMemorySize, MK_LDS_BYTES) != hipSuccess) { fprintf(stderr, "kernel_launch: hipFuncSetAttribute failed\n"); grid = -1; return; }
        if (hipOccupancyMaxActiveBlocksPerMultiprocessor(&per_cu, (const void*)mk::mk_fwd, 512, MK_LDS_BYTES) != hipSuccess || per_cu < 1) { per_cu = 1; (void)hipGetLastError(); }
        grid = cus;
    }
    if (grid < 0) return;
    if (hipMemsetAsync((char*)d_ws + mk::WS_BAR, 0, XCD_BAR_WORDS * sizeof(unsigned), stream) != hipSuccess) { fprintf(stderr, "kernel_launch: memset of barrier words failed\n"); return; }
    mk::Args a{};
    for (int i = 0; i < 14; ++i) a.in[i] = (const float*)d_in[i];
    a.out = (float*)d_out; a.ws = (unsigned char*)d_ws;
#if MK_ONE_LAUNCH
    a.ph_lo = 0; a.ph_hi = 11;
    void* args[] = {&a};
    hipError_t e = hipLaunchCooperativeKernel((const void*)mk::mk_fwd, dim3(grid), dim3(512), args, MK_LDS_BYTES, stream);
    if (e != hipSuccess) fprintf(stderr, "kernel_launch: cooperative launch failed: %s (grid %d)\n", hipGetErrorString(e), grid);
#else
    for (int ph = 0; ph < 11; ++ph) { a.ph_lo = ph; a.ph_hi = ph + 1; hipLaunchKernelGGL(mk::mk_fwd, dim3(grid), dim3(512), MK_LDS_BYTES, stream, a); }
#endif
}
```

```cpp
#include <hip/hip_runtime.h>
#include <hip/hip_cooperative_groups.h>
#include <cstdio>
#include <cstdint>
namespace pg8 {
#define PG8_LAS __attribute__((address_space(3)))
typedef unsigned short bf16_t;
typedef short bf16x8 __attribute__((ext_vector_type(8)));
typedef float f32x4 __attribute__((ext_vector_type(4)));
typedef unsigned u32x4 __attribute__((ext_vector_type(4)));
constexpr int BM = 256, BK = 64, HALF = 128, HTB = HALF * BK * 2  , STAGE_BYTES = 8 * HTB, NXCD = 8, WGM = 8;

__host__ __device__ __forceinline__ int lds_byte(int r, int c) { const int st = (r >> 4) * 2 + (c >> 5), rr = r & 15, cc = c & 31, ob = rr * 64 + cc * 2; return st * 1024 + (ob ^ (((ob >> 9) & 1) << 5)); }
__host__ __device__ __forceinline__ void stage_rc(int b, int& R, int& C) { const int st = b / 1024, sb = b % 1024, swz = sb ^ (((sb >> 9) & 1) << 5); R = (st >> 1) * 16 + swz / 64; C = (st & 1) * 32 + (swz % 64) / 2; }
__host__ __device__ __forceinline__ int perm32(int rho) { const int n = rho >> 4, i = rho & 15; return 8 * (i >> 2) + 4 * n + (i & 3); }

struct Unit { int pm, pn; };
struct Gemm { const bf16_t* A; const bf16_t* Bt; int M, N, K; };

struct StaticOrder {
    int nM, nN, nwg, G, c;
    __host__ __device__ void init(int M, int N, int G_, int c_) { nM = M / BM; nN = N / BM; nwg = nM * nN; G = G_; c = c_; }
    __host__ __device__ bool next(int i, Unit& u) const {
        const long L = (long)i * G + c; if (L >= nwg) return false;
        int wgid = (int)L; { const int q = nwg / NXCD, r = nwg % NXCD, xcd = wgid % NXCD, off = wgid / NXCD; wgid = (xcd < r ? xcd * (q + 1) : r * (q + 1) + (xcd - r) * q) + off; }
        const int nig = WGM * nN, gid = wgid / nig, fm = gid * WGM, gsz = (nM - fm) < WGM ? (nM - fm) : WGM;
        u.pm = fm + ((wgid % nig) % gsz); u.pn = (wgid % nig) / gsz; return true;
    }
    __device__ __forceinline__ void a_ready(const Unit&) const {}
    __device__ __forceinline__ void done(const Unit&) const {}
};
__device__ __forceinline__ unsigned cvt_pk_bf16(float lo, float hi) { unsigned r; asm volatile("v_cvt_pk_bf16_f32 %0, %1, %2" : "=v"(r) : "v"(lo), "v"(hi)); return r; }
template <class Epi, class Sched, bool ALIGN_EPI = false, bool SP2 = false>
__device__ __forceinline__ void gemm_phase(PG8_LAS unsigned char* lds, const Gemm g, const Sched& S, const Epi& E) {
    const int tid = threadIdx.x, wid = __builtin_amdgcn_readfirstlane(tid >> 6), lane = tid & 63, wr = wid >> 2, wc = wid & 3, fr = lane & 15, fq = lane >> 4;
    const int K = g.K, nt = K / BK;
    unsigned voffA[2], voffB[2];
#pragma unroll
    for (int i = 0; i < 2; ++i) { int R, C; stage_rc(tid * 16 + i * 8192, R, C); const int Rb = Epi::PERM ? ((R & ~31) + perm32(R & 31)) : R;
        voffA[i] = (unsigned)(R * K + C) * 2u; voffB[i] = (unsigned)(Rb * K + C) * 2u; }
    const size_t kstep = (size_t)(BK * 2);
    const size_t hstep = (size_t)HALF * K * 2;
    const size_t tstep = 2 * hstep;
    const unsigned ldsw = (unsigned)wid * 1024u;
    const int aoff = lds_byte(wr * 64 + fr, fq * 8), boff = lds_byte(wc * 32 + fr, fq * 8);
#define PG8_SA(b, h) (((b) * 2 + (h)) * HTB)
#define PG8_SB(b, h) ((4 + (b) * 2 + (h)) * HTB)
#define PG8_STAGE(bufoff, gbase, voff) do { _Pragma("unroll") for (int _i = 0; _i < 2; ++_i) \
        __builtin_amdgcn_global_load_lds((const unsigned*)((const char*)(gbase) + (voff)[_i]), (PG8_LAS unsigned*)(lds + (bufoff) + ldsw + _i * 8192), 16, 0, 0); } while (0)
#define PG8_LDA(dst, b, h) do { _Pragma("unroll") for (int m = 0; m < 4; ++m) _Pragma("unroll") for (int k = 0; k < 2; ++k) dst[m][k] = *(const PG8_LAS bf16x8*)(lds + PG8_SA(b, h) + aoff + m * 2048 + k * 1024); } while (0)
#define PG8_LDB(dst, b, h) do { _Pragma("unroll") for (int n = 0; n < 2; ++n) _Pragma("unroll") for (int k = 0; k < 2; ++k) dst[n][k] = *(const PG8_LAS bf16x8*)(lds + PG8_SB(b, h) + boff + n * 2048 + k * 1024); } while (0)
#define PG8_MMA(ai, bj, At, Bt) do { __builtin_amdgcn_s_setprio(1); _Pragma("unroll") for (int m = 0; m < 4; ++m) _Pragma("unroll") for (int n = 0; n < 2; ++n) _Pragma("unroll") for (int k = 0; k < 2; ++k) \
        acc[ai][bj][m][n] = __builtin_amdgcn_mfma_f32_16x16x32_bf16(Bt[n][k], At[m][k], acc[ai][bj][m][n], 0, 0, 0); __builtin_amdgcn_s_setprio(0); } while (0)
#define PG8_WAIT_V(n) asm volatile("s_waitcnt vmcnt(" #n ")" ::: "memory")
#define PG8_WAIT_L(n) asm volatile("s_waitcnt lgkmcnt(" #n ")" ::: "memory")
#define PG8_BAR __builtin_amdgcn_s_barrier()
#define PG8_SCHED __builtin_amdgcn_sched_barrier(0)
    Unit cur, nxt; int ui = 0;
    if (!S.next(0, cur)) return;
    f32x4 acc[2][2][4][2];
#pragma unroll
    for (int a = 0; a < 2; ++a)
#pragma unroll
        for (int b = 0; b < 2; ++b)
#pragma unroll
            for (int m = 0; m < 4; ++m)
#pragma unroll
                for (int n = 0; n < 2; ++n) acc[a][b][m][n] = (f32x4){0.f, 0.f, 0.f, 0.f};
    bf16x8 At[4][2], B0[2][2], B1[2][2];
    const char* cA = (const char*)g.A + (size_t)cur.pm * tstep; const char* cB = (const char*)g.Bt + (size_t)cur.pn * tstep;
    S.a_ready(cur);
    if constexpr (SP2) {
        PG8_STAGE(PG8_SB(0, 0), cB, voffB); PG8_STAGE(PG8_SB(0, 1), cB + hstep, voffB); PG8_STAGE(PG8_SA(0, 0), cA, voffA); PG8_STAGE(PG8_SA(0, 1), cA + hstep, voffA);
        if (wr == 1) PG8_BAR;
        PG8_WAIT_V(2); PG8_BAR;
        PG8_STAGE(PG8_SB(1, 0), cB + kstep, voffB); PG8_STAGE(PG8_SA(1, 0), cA + kstep, voffA); PG8_STAGE(PG8_SB(1, 1), cB + hstep + kstep, voffB);
        PG8_WAIT_V(6); PG8_BAR;
    } else {
        PG8_STAGE(PG8_SB(0, 0), cB, voffB); PG8_STAGE(PG8_SA(0, 0), cA, voffA); PG8_STAGE(PG8_SB(0, 1), cB + hstep, voffB); PG8_STAGE(PG8_SA(0, 1), cA + hstep, voffA);
        if (wr == 1) PG8_BAR;
        PG8_WAIT_V(4); PG8_BAR;
        PG8_STAGE(PG8_SB(1, 0), cB + kstep, voffB); PG8_STAGE(PG8_SA(1, 0), cA + kstep, voffA); PG8_STAGE(PG8_SB(1, 1), cB + hstep + kstep, voffB);
        PG8_WAIT_V(6); PG8_BAR;
    }
    for (;;) {
        const bool has_next = S.next(ui + 1, nxt);
        const char* nA = has_next ? (const char*)g.A + (size_t)nxt.pm * tstep : cA; const char* nB = has_next ? (const char*)g.Bt + (size_t)nxt.pn * tstep : cB;
        for (int t = 0; t < nt; t += 2) {
            const bool last = (t == nt - 2);
            const char* a1 = cA + (size_t)(t + 1) * kstep;
            const char* a2 = last ? nA : cA + (size_t)(t + 2) * kstep; const char* b2 = last ? nB : cB + (size_t)(t + 2) * kstep;
            const char* a3 = a2 + kstep; const char* b3 = b2 + kstep;
            if (last && has_next) S.a_ready(nxt);
            if constexpr (SP2) {
            PG8_LDB(B0, 0, 0); PG8_LDB(B1, 0, 1); PG8_SCHED; PG8_LDA(At, 0, 0); PG8_STAGE(PG8_SA(1, 1), a1 + hstep, voffA);
            PG8_WAIT_V(8); PG8_WAIT_L(0); PG8_BAR; PG8_MMA(0, 0, At, B0); PG8_MMA(0, 1, At, B1); PG8_BAR; PG8_SCHED;
            PG8_LDA(At, 0, 1); PG8_STAGE(PG8_SB(0, 0), b2, voffB); PG8_STAGE(PG8_SB(0, 1), b2 + hstep, voffB); PG8_STAGE(PG8_SA(0, 0), a2, voffA);
            PG8_WAIT_V(8); PG8_WAIT_L(0); PG8_BAR; PG8_MMA(1, 0, At, B0); PG8_MMA(1, 1, At, B1); PG8_BAR; PG8_SCHED;
            PG8_LDB(B0, 1, 0); PG8_LDB(B1, 1, 1); PG8_SCHED; PG8_LDA(At, 1, 0); PG8_STAGE(PG8_SA(0, 1), a2 + hstep, voffA);
            PG8_WAIT_V(8); PG8_WAIT_L(0); PG8_BAR; PG8_MMA(0, 0, At, B0); PG8_MMA(0, 1, At, B1); PG8_BAR; PG8_SCHED;
            PG8_LDA(At, 1, 1); PG8_STAGE(PG8_SB(1, 0), b3, voffB); PG8_STAGE(PG8_SB(1, 1), b3 + hstep, voffB); PG8_STAGE(PG8_SA(1, 0), a3, voffA);
            PG8_WAIT_V(8); PG8_WAIT_L(0); PG8_BAR; PG8_MMA(1, 0, At, B0); PG8_MMA(1, 1, At, B1); PG8_BAR; PG8_SCHED;
            } else {
            PG8_LDB(B0, 0, 0); PG8_SCHED; PG8_LDA(At, 0, 0); PG8_STAGE(PG8_SA(1, 1), a1 + hstep, voffA);
            PG8_WAIT_L(8); PG8_BAR; PG8_WAIT_L(0); PG8_MMA(0, 0, At, B0); PG8_BAR; PG8_SCHED;
            PG8_LDB(B1, 0, 1); PG8_STAGE(PG8_SB(0, 0), b2, voffB);
            PG8_BAR; PG8_WAIT_L(0); PG8_MMA(0, 1, At, B1); PG8_BAR;
            PG8_LDA(At, 0, 1); PG8_STAGE(PG8_SA(0, 0), a2, voffA);
            PG8_BAR; PG8_WAIT_L(0); PG8_MMA(1, 0, At, B0); PG8_BAR; PG8_SCHED;
            PG8_STAGE(PG8_SB(0, 1), b2 + hstep, voffB);
            PG8_WAIT_V(6); PG8_BAR; PG8_MMA(1, 1, At, B1); PG8_BAR;
            PG8_LDB(B0, 1, 0); PG8_SCHED; PG8_LDA(At, 1, 0); PG8_STAGE(PG8_SA(0, 1), a2 + hstep, voffA);
            PG8_WAIT_L(8); PG8_BAR; PG8_WAIT_L(0); PG8_MMA(0, 0, At, B0); PG8_BAR; PG8_SCHED;
            PG8_LDB(B1, 1, 1); PG8_STAGE(PG8_SB(1, 0), b3, voffB);
            PG8_BAR; PG8_WAIT_L(0); PG8_MMA(0, 1, At, B1); PG8_BAR;
            PG8_LDA(At, 1, 1); PG8_STAGE(PG8_SA(1, 0), a3, voffA);
            PG8_BAR; PG8_WAIT_L(0); PG8_MMA(1, 0, At, B0); PG8_BAR; PG8_SCHED;
            PG8_STAGE(PG8_SB(1, 1), b3 + hstep, voffB);
            PG8_WAIT_V(6); PG8_BAR; PG8_MMA(1, 1, At, B1); PG8_BAR;
            }
        }
        if constexpr (ALIGN_EPI) { if (wr == 0) PG8_BAR; }
        if constexpr (!Epi::AFTER_DRAIN) { E(acc, cur, wr, wc, fr, fq); S.done(cur); }
        if (!has_next) break;
#pragma unroll
        for (int a = 0; a < 2; ++a)
#pragma unroll
            for (int b = 0; b < 2; ++b)
#pragma unroll
                for (int m = 0; m < 4; ++m)
#pragma unroll
                    for (int n = 0; n < 2; ++n) acc[a][b][m][n] = (f32x4){0.f, 0.f, 0.f, 0.f};
        cur = nxt; cA = nA; cB = nB; ++ui;
        if constexpr (ALIGN_EPI) { if (wr == 1) PG8_BAR; }
    }
    PG8_WAIT_V(0);
    if constexpr (!ALIGN_EPI) { if (wr == 0) PG8_BAR; }
    PG8_BAR;
    if constexpr (Epi::AFTER_DRAIN) { E.fused(acc, cur, wr, wc, fr, fq, lds, wid, lane); S.done(cur); }
#undef PG8_SA
#undef PG8_SB
#undef PG8_STAGE
#undef PG8_LDA
#undef PG8_LDB
#undef PG8_MMA
#undef PG8_WAIT_V
#undef PG8_WAIT_L
#undef PG8_BAR
#undef PG8_SCHED
}
}
#define XB_TMO      128
#define XB_XCNT(j)  (256  + 64 * (j))
#define XB_XSUB(j)  (1280 + 64 * (j))
#define XB_XGEN(j)  (2304 + 64 * (j))
#define XB_TOP      3328
#define XB_TOPGEN   3392
#define XCD_BAR_WORDS 3456
#define XB_SPIN_CAP (1u << 18)
#define LAS __attribute__((address_space(3)))

__device__ __forceinline__ unsigned xb_ld(unsigned* p)              { return __hip_atomic_load(p, __ATOMIC_RELAXED, __HIP_MEMORY_SCOPE_AGENT); }
__device__ __forceinline__ unsigned xb_add(unsigned* p, unsigned v) { return __hip_atomic_fetch_add(p, v, __ATOMIC_RELAXED, __HIP_MEMORY_SCOPE_AGENT); }
__device__ __forceinline__ unsigned xb_xcc_id() { return (unsigned)__builtin_amdgcn_s_getreg((3 << 11) | 20) & 0xFu; }
#define XB_SPIN(cond, bar) do { unsigned _sp = 0; while (cond) { __builtin_amdgcn_s_sleep(1); \
    if ((++_sp & 255u) == 0u) { if (xb_ld(&(bar)[XB_TMO])) break; if (_sp > XB_SPIN_CAP) { atomicAdd(&(bar)[XB_TMO], 1u); break; } } } } while (0)

struct XcdBarrier {
    unsigned* bar; unsigned x;
    volatile LAS unsigned* st;
};

__device__ __forceinline__ XcdBarrier xcd_barrier_post(unsigned* bar, volatile LAS unsigned* st) {
    XcdBarrier b; b.bar = bar; b.x = xb_xcc_id(); b.st = st;
    if (threadIdx.x == 0) (void)xb_add(&bar[XB_XCNT(b.x)], 1u);
    return b;
}
__device__ __forceinline__ void xcd_barrier_complete(unsigned* bar, unsigned x, unsigned& nloc, unsigned& nx) {
    const unsigned G = gridDim.x * gridDim.y * gridDim.z;
    unsigned sum, cnt, mine, sp = 0u;
    for (;;) {
        sum = 0u; cnt = 0u; mine = 0u;
#pragma unroll
        for (unsigned j = 0; j < 16; ++j) { const unsigned c = xb_ld(&bar[XB_XCNT(j)]); sum += c; cnt += (c > 0u) ? 1u : 0u; mine = (j == x) ? c : mine; }
        if (sum == G) break;
        __builtin_amdgcn_s_sleep(1);
        if ((++sp & 255u) == 0u) { if (xb_ld(&bar[XB_TMO])) break; if (sp > XB_SPIN_CAP) { atomicAdd(&bar[XB_TMO], 1u); break; } }
    }
    nloc = mine > 0u ? mine : 1u; nx = cnt > 0u ? cnt : 1u;
}

__device__ __forceinline__ void xcd_barrier(const XcdBarrier& b) {
    asm volatile("s_waitcnt vmcnt(0)" ::: "memory");
    __syncthreads();
    if (threadIdx.x == 0) {
        unsigned* bar = b.bar;
        __builtin_amdgcn_s_waitcnt(0);
        unsigned nloc = b.st[0], nx = b.st[1];
        if (nloc == 0u) { xcd_barrier_complete(bar, b.x, nloc, nx); b.st[0] = nloc; b.st[1] = nx; }
        const unsigned old = xb_add(&bar[XB_XSUB(b.x)], 1u);
        const unsigned gen = old / nloc;
        if (old + 1u == (gen + 1u) * nloc) {
            __builtin_amdgcn_fence(__ATOMIC_RELEASE, "agent");
            asm volatile("s_waitcnt vmcnt(0)" ::: "memory");
            const unsigned og = xb_add(&bar[XB_TOP], 1u);
            const unsigned tg = og / nx;
            if (og + 1u == (tg + 1u) * nx) xb_add(&bar[XB_TOPGEN], 1u);
            else XB_SPIN(xb_ld(&bar[XB_TOPGEN]) == tg, bar);
            __builtin_amdgcn_fence(__ATOMIC_ACQUIRE, "agent");
            xb_add(&bar[XB_XGEN(b.x)], 1u);
            asm volatile("s_waitcnt vmcnt(0)" ::: "memory");
        } else {
            XB_SPIN(xb_ld(&bar[XB_XGEN(b.x)]) == gen, bar);
            __builtin_amdgcn_fence(__ATOMIC_ACQUIRE, "agent");
            asm volatile("s_waitcnt vmcnt(0)" ::: "memory");
        }
    }
    __syncthreads();
}

namespace cg = cooperative_groups;
namespace mk {
using pg8::bf16_t; using pg8::bf16x8; using pg8::f32x4; using pg8::u32x4; using pg8::Unit; using pg8::Gemm;
typedef float f32x16 __attribute__((ext_vector_type(16)));
typedef float f32x2 __attribute__((ext_vector_type(2)));
typedef unsigned u32x2 __attribute__((ext_vector_type(2)));
typedef __bf16 bf16x2_t __attribute__((ext_vector_type(2)));

constexpr int D = 1024, NB = 8, S = 4096, M = NB * S, NT = 512;
constexpr float EPS = 1e-6f, LOG2E = 1.4426950408889634f, QSCALE = 0.125f * 1.4426950408889634f;
constexpr size_t MiB = 1ull << 20;
constexpr size_t WS_MOD = 0;
constexpr size_t WS_BAR = 200704;
constexpr size_t WS_W0A = 256 * 1024;
constexpr size_t WS_WV  = WS_W0A + 10 * MiB;
constexpr size_t WS_WO0 = WS_WV + 2 * MiB;
constexpr size_t WS_WP  = WS_WO0 + 4 * MiB;
constexpr size_t WS_W1  = WS_WP + MiB / 2;
constexpr size_t WS_WO1 = WS_W1 + 16 * MiB;
constexpr size_t WS_H   = WS_WO1 + 4 * MiB;
constexpr size_t WS_BIG = WS_H + 64 * MiB;
constexpr size_t WS_U = WS_BIG, WS_Q = WS_BIG + 64 * MiB, WS_K = WS_BIG + 128 * MiB, WS_VT = WS_BIG + 192 * MiB, WS_G = WS_BIG + 256 * MiB;
constexpr size_t WS_UP = WS_BIG, WS_G1 = WS_BIG + 128 * MiB;
constexpr size_t WS_END = WS_BIG + 384 * MiB;
constexpr size_t WS_STATS = WS_END;
constexpr size_t WS_GS = WS_STATS + 512 * 1024;
constexpr size_t WS_SHW = WS_GS + 32 * 1024;
constexpr size_t WS_WINP = WS_SHW + 256 * 1024;
constexpr size_t WS_END2 = WS_WINP + 2 * MiB;

struct Args { const float* in[14]; float* out; unsigned char* ws; int ph_lo, ph_hi; };

#define MK_DI __device__ __forceinline__
MK_DI unsigned pk(float lo, float hi) { f32x2 v = {lo, hi}; return __builtin_bit_cast(unsigned, __builtin_convertvector(v, bf16x2_t)); }
MK_DI int lane_id() { return (int)__builtin_amdgcn_mbcnt_hi(~0u, __builtin_amdgcn_mbcnt_lo(~0u, 0u)); }
MK_DI int wave_id() { return __builtin_amdgcn_readfirstlane((int)(threadIdx.x >> 6)); }
MK_DI float bflo(unsigned w) { return __uint_as_float(w << 16); }
MK_DI float bfhi(unsigned w) { return __uint_as_float(w & 0xffff0000u); }
MK_DI float silu_f(float v) { return v * __builtin_amdgcn_rcpf(1.0f + __builtin_amdgcn_exp2f(-v * LOG2E)); }
MK_DI void unpack8(const u32x4 w, float (&f)[8]) { f[0] = bflo(w.x); f[1] = bfhi(w.x); f[2] = bflo(w.y); f[3] = bfhi(w.y); f[4] = bflo(w.z); f[5] = bfhi(w.z); f[6] = bflo(w.w); f[7] = bfhi(w.w); }
MK_DI u32x4 pack8(const float (&f)[8]) { u32x4 w; w.x = pk(f[0], f[1]); w.y = pk(f[2], f[3]); w.z = pk(f[4], f[5]); w.w = pk(f[6], f[7]); return w; }

MK_DI void p0_adaln(const float* c, const float* ada_w, const float* ada_b, float* mod, float* sm) {
    const int tid = threadIdx.x;
    for (int blk = blockIdx.x; blk < 192; blk += gridDim.x) {
        for (int i = tid; i < 8192; i += NT) sm[i] = silu_f(c[i]);
        __syncthreads();
        const int col = tid & 31, ks = tid >> 5;
        const int gcn = blk * 32 + col, l = gcn / 3072, n = gcn % 3072;
        float acc[8];
#pragma unroll
        for (int b = 0; b < 8; ++b) acc[b] = 0.f;
        const float* w = ada_w + (size_t)l * 1024 * 3072 + n;
        for (int kk0 = 0; kk0 < 64; kk0 += 16) {
            float wv[16];
#pragma unroll
            for (int u = 0; u < 16; ++u) wv[u] = w[(size_t)(ks + 16 * (kk0 + u)) * 3072];
#pragma unroll
            for (int u = 0; u < 16; ++u) {
                const int k = ks + 16 * (kk0 + u);
#pragma unroll
                for (int b = 0; b < 8; ++b) acc[b] += sm[b * 1024 + k] * wv[u];
            }
        }
        float* red = sm + 8192;
#pragma unroll
        for (int b = 0; b < 8; ++b) red[(ks * 32 + col) * 8 + b] = acc[b];
        __syncthreads();
        if (tid < 256) {
            const int cc = tid & 31, b = tid >> 5; float s = 0.f;
            for (int k2 = 0; k2 < 16; ++k2) s += red[(k2 * 32 + cc) * 8 + b];
            const int g2 = blk * 32 + cc, l2 = g2 / 3072, n2 = g2 % 3072;
            mod[(l2 * 8 + b) * 3072 + n2] = s + ada_b[l2 * 3072 + n2];
        }
        __syncthreads();
    }
}

MK_DI void p0_transpose(const Args& a, float* sm) {
    const int tid = threadIdx.x;
    unsigned char* ws = a.ws;
    for (int i = blockIdx.x * NT + tid; i < 131072; i += gridDim.x * NT) {
        const int c8 = i & 31, k = (i >> 5) & 1023, g = i >> 15;
        const float* sp = a.in[5] + (size_t)k * 6144 + g * 256 + c8 * 8;
        const f32x4 v0 = *(const f32x4*)sp, v1 = *(const f32x4*)(sp + 4);
        u32x4 w; w.x = pk(v0.x, v0.y); w.y = pk(v0.z, v0.w); w.z = pk(v1.x, v1.y); w.w = pk(v1.z, v1.w);
        *(u32x4*)((bf16_t*)(ws + WS_WINP) + ((size_t)g * 1024 + k) * 256 + c8 * 8) = w;
    }
    for (int t = blockIdx.x; t < 1104; t += gridDim.x) {
        const float* src; bf16_t* dst; int ld, K, tn, tk, mode;
        if (t < 256)       { src = a.in[5];  ld = 6144; K = 1024; tn = 16 + (t >> 2); tk = t & 3; mode = 0; dst = (bf16_t*)(ws + WS_W0A); }
        else if (t < 320)  { const int u = t - 256; src = a.in[5] + 3072; ld = 6144; K = 1024; tn = u >> 2; tk = u & 3; mode = 1; dst = (bf16_t*)(ws + WS_WV); }
        else if (t < 448)  { const int u = t - 320; src = a.in[8];  ld = 1024; K = 2048; tn = u >> 3; tk = u & 7; mode = 1; dst = (bf16_t*)(ws + WS_WO0); }
        else if (t < 464)  { const int u = t - 448, g = u >> 2; src = a.in[6] + g * 65536; ld = 256; K = 256; tn = u & 3; tk = 0; mode = 1; dst = (bf16_t*)(ws + WS_WP) + g * 65536; }
        else if (t < 976)  { const int u = t - 464; src = a.in[9];  ld = 8192; K = 1024; tn = u >> 2; tk = u & 3; mode = 2; dst = (bf16_t*)(ws + WS_W1); }
        else               { const int u = t - 976; src = a.in[12]; ld = 1024; K = 2048; tn = u >> 3; tk = u & 7; mode = 1; dst = (bf16_t*)(ws + WS_WO1); }
        const int nn = tid & 63, n1 = tn * 64 + nn, kr = tid >> 6;
        int col;
        if (mode == 0) col = n1 < 3072 ? n1 : n1 + 1024;
        else if (mode == 1) col = n1;
        else { const int pn = n1 >> 8, bj = (n1 >> 7) & 1, wc = (n1 >> 5) & 3, n = (n1 >> 4) & 1, fq = (n1 >> 2) & 3, j = n1 & 3; col = (2 * bj + n) * 2048 + 64 * pn + 16 * wc + 4 * fq + j; }
        const float* sp = src + (size_t)(tk * 256 + kr) * ld + col;
        float v[32];
#pragma unroll
        for (int e = 0; e < 32; ++e) v[e] = sp[(size_t)(8 * e) * ld];
#pragma unroll
        for (int e = 0; e < 32; ++e) sm[nn * 257 + kr + 8 * e] = v[e];
        __syncthreads();
#pragma unroll
        for (int i = 0; i < 4; ++i) {
            const int p = tid + 512 * i, wn = p & 63, kc = (p >> 6) * 8;
            float f[8];
#pragma unroll
            for (int j = 0; j < 8; ++j) f[j] = sm[wn * 257 + kc + j];
            *(u32x4*)(dst + (size_t)(tn * 64 + wn) * K + tk * 256 + kc) = pack8(f);
        }
        __syncthreads();
    }
}

MK_DI float wave_sum(float v) {
#pragma unroll
    for (int off = 32; off >= 1; off >>= 1) v += __shfl_xor(v, off);
    return v;
}
MK_DI void p_norm_mod(const float* xin, const float* g, const float* modl, bf16_t* H) {
    const int tid = threadIdx.x, lane = lane_id(), wid = wave_id(), stride = gridDim.x * 8;
    for (int rowa = blockIdx.x * 8 + wid; rowa < M; rowa += 2 * stride) {
        const bool ok1 = rowa + stride < M;
        int rows[2]; rows[0] = rowa; rows[1] = ok1 ? rowa + stride : rowa;
        f32x4 v[2][4];
#pragma unroll
        for (int q = 0; q < 2; ++q)
#pragma unroll
            for (int j = 0; j < 4; ++j) v[q][j] = *(const f32x4*)(xin + (size_t)rows[q] * D + 4 * lane + 256 * j);
#pragma unroll
        for (int q = 0; q < 2; ++q) {
            float ss = 0.f;
#pragma unroll
            for (int j = 0; j < 4; ++j) ss += v[q][j].x * v[q][j].x + v[q][j].y * v[q][j].y + v[q][j].z * v[q][j].z + v[q][j].w * v[q][j].w;
            ss = wave_sum(ss);
            const float rstd = rsqrtf(ss * (1.0f / 1024.0f) + EPS);
            const float* mb = modl + (rows[q] >> 12) * 3072 + 4 * lane;
            if (q == 0 || ok1) {
#pragma unroll
                for (int j = 0; j < 4; ++j) {
                    const f32x4 gv = *(const f32x4*)(g + 4 * lane + 256 * j), sh = *(const f32x4*)(mb + 256 * j), sc = *(const f32x4*)(mb + 1024 + 256 * j);
                    const f32x4 hh = (v[q][j] * rstd) * gv * (sc + 1.0f) + sh;
                    u32x2 w; w.x = pk(hh.x, hh.y); w.y = pk(hh.z, hh.w);
                    *(u32x2*)(H + (size_t)rows[q] * D + 4 * lane + 256 * j) = w;
                }
            }
        }
    }
}
MK_DI void p_final_norm(float* xo, const float* g) {
    const int tid = threadIdx.x, lane = lane_id(), wid = wave_id(), stride = gridDim.x * 8;
    for (int rowa = blockIdx.x * 8 + wid; rowa < M; rowa += 2 * stride) {
        const bool ok1 = rowa + stride < M;
        int rows[2]; rows[0] = rowa; rows[1] = ok1 ? rowa + stride : rowa;
        f32x4 v[2][4];
#pragma unroll
        for (int q = 0; q < 2; ++q)
#pragma unroll
            for (int j = 0; j < 4; ++j) v[q][j] = *(const f32x4*)(xo + (size_t)rows[q] * D + 4 * lane + 256 * j);
#pragma unroll
        for (int q = 0; q < 2; ++q) {
            float ss = 0.f;
#pragma unroll
            for (int j = 0; j < 4; ++j) ss += v[q][j].x * v[q][j].x + v[q][j].y * v[q][j].y + v[q][j].z * v[q][j].z + v[q][j].w * v[q][j].w;
            ss = wave_sum(ss);
            const float rstd = rsqrtf(ss * (1.0f / 1024.0f) + EPS);
            if (q == 0 || ok1) {
#pragma unroll
                for (int j = 0; j < 4; ++j) { const f32x4 gv = *(const f32x4*)(g + 4 * lane + 256 * j); *(f32x4*)(xo + (size_t)rows[q] * D + 4 * lane + 256 * j) = (v[q][j] * rstd) * gv; }
            }
        }
    }
}

MK_DI void p1_side(const float* g1, const float* mod1, const bf16_t* Wt1, float* gs, float* stats, float* shW, float* sm) {
    const int tid = threadIdx.x, lane = lane_id(), wid = wave_id();
    if (blockIdx.x == 0) for (int i = tid; i < 8192; i += NT) gs[i] = g1[i & 1023] * (1.0f + mod1[(i >> 10) * 3072 + 1024 + (i & 1023)]);
    for (int i = tid; i < 8192; i += NT) sm[i] = mod1[(i >> 10) * 3072 + (i & 1023)];
    __syncthreads();
    for (int n = blockIdx.x * 8 + wid; n < 8192; n += gridDim.x * 8) {
        float w[16];
        { float f[8]; unpack8(*(const u32x4*)(Wt1 + (size_t)n * 1024 + lane * 16), f);
#pragma unroll
          for (int j = 0; j < 8; ++j) w[j] = f[j];
          unpack8(*(const u32x4*)(Wt1 + (size_t)n * 1024 + lane * 16 + 8), f);
#pragma unroll
          for (int j = 0; j < 8; ++j) w[8 + j] = f[j]; }
        float sb[8];
#pragma unroll
        for (int b = 0; b < 8; ++b) {
            float s = 0.f;
#pragma unroll
            for (int j4 = 0; j4 < 4; ++j4) { const f32x4 sv = *(const f32x4*)(sm + b * 1024 + lane * 16 + 4 * j4); s += sv.x * w[4 * j4] + sv.y * w[4 * j4 + 1] + sv.z * w[4 * j4 + 2] + sv.w * w[4 * j4 + 3]; }
            sb[b] = wave_sum(s);
        }
        if (lane == 0) {
#pragma unroll
            for (int b = 0; b < 8; ++b) shW[b * 8192 + n] = sb[b];
        }
    }
    __syncthreads();
}

struct EpiProj0 {
    static constexpr bool PERM = true, AFTER_DRAIN = false;
    bf16_t *U, *Q, *Kh, *G;
    MK_DI void operator()(const f32x4 (&acc)[2][2][4][2], const Unit& u, int wr, int wc, int fr, int fq) const {
        const int reg = u.pn >> 2, row0 = u.pm * 256 + wr * 64 + fr, cb = u.pn * 256 + wc * 32 + 8 * fq;
#pragma unroll
        for (int ai = 0; ai < 2; ++ai)
#pragma unroll
            for (int m = 0; m < 4; ++m) {
                const int row = row0 + ai * 128 + m * 16;
#pragma unroll
                for (int bj = 0; bj < 2; ++bj) {
                    const int c = cb + bj * 128; f32x4 v0 = acc[ai][bj][m][0], v1 = acc[ai][bj][m][1]; bf16_t* ptr;
                    if (reg == 0) ptr = U + (size_t)row * 1024 + c;
                    else if (reg == 1) { v0 *= QSCALE; v1 *= QSCALE; ptr = Q + (size_t)row * 1024 + (c - 1024); }
                    else if (reg == 2) { const int cc = c - 2048; ptr = Kh + ((size_t)((row >> 12) * 16 + (cc >> 6)) * 4096 + (row & 4095)) * 64 + (cc & 63); }
                    else { v0.x = silu_f(v0.x); v0.y = silu_f(v0.y); v0.z = silu_f(v0.z); v0.w = silu_f(v0.w); v1.x = silu_f(v1.x); v1.y = silu_f(v1.y); v1.z = silu_f(v1.z); v1.w = silu_f(v1.w);
                           ptr = G + (size_t)row * 2048 + (c - 3072); }
                    u32x4 w; w.x = pk(v0.x, v0.y); w.y = pk(v0.z, v0.w); w.z = pk(v1.x, v1.y); w.w = pk(v1.z, v1.w);
                    *(u32x4*)ptr = w;
                }
            }
    }
};
struct EpiVt {
    static constexpr bool PERM = true, AFTER_DRAIN = false;
    bf16_t* Vt;
    MK_DI void operator()(const f32x4 (&acc)[2][2][4][2], const Unit& u, int wr, int wc, int fr, int fq) const {
        const int row0 = u.pm * 256 + wr * 64 + fr, cb = u.pn * 256 + wc * 32 + 8 * fq;
#pragma unroll
        for (int ai = 0; ai < 2; ++ai)
#pragma unroll
            for (int m = 0; m < 4; ++m) {
                const int row = row0 + ai * 128 + m * 16;
#pragma unroll
                for (int bj = 0; bj < 2; ++bj) {
                    const f32x4 v0 = acc[ai][bj][m][0], v1 = acc[ai][bj][m][1];
                    u32x4 w; w.x = pk(v0.x, v0.y); w.y = pk(v0.z, v0.w); w.z = pk(v1.x, v1.y); w.w = pk(v1.z, v1.w);
                    *(u32x4*)(Vt + (size_t)row * 32768 + cb + bj * 128) = w;
                }
            }
    }
};
struct EpiRes {
    static constexpr bool PERM = false, AFTER_DRAIN = false;
    const float* res; float* out; const float* gate;
    MK_DI void operator()(const f32x4 (&acc)[2][2][4][2], const Unit& u, int wr, int wc, int fr, int fq) const {
        const int row0 = u.pm * 256 + wr * 64 + fr, col0 = u.pn * 256 + wc * 32 + 4 * fq, b = (u.pm * 256) >> 12;
        f32x4 gv[2][2];
#pragma unroll
        for (int bj = 0; bj < 2; ++bj)
#pragma unroll
            for (int n = 0; n < 2; ++n) gv[bj][n] = *(const f32x4*)(gate + b * 3072 + col0 + bj * 128 + n * 16) + 1.0f;
#pragma unroll
        for (int ai = 0; ai < 2; ++ai)
#pragma unroll
            for (int m = 0; m < 4; ++m) {
                const size_t off = (size_t)(row0 + ai * 128 + m * 16) * 1024 + col0;
#pragma unroll
                for (int bj = 0; bj < 2; ++bj)
#pragma unroll
                    for (int n = 0; n < 2; ++n) { const size_t o = off + bj * 128 + n * 16; const f32x4 r = *(const f32x4*)(res + o); *(f32x4*)(out + o) = r + gv[bj][n] * acc[ai][bj][m][n]; }
            }
    }
};
struct EpiResNorm {
    static constexpr bool PERM = false, AFTER_DRAIN = false;
    const float* res; float* out; const float* gate; const float* gs; bf16_t* Hn; float* stats; float* sred;
    MK_DI void operator()(const f32x4 (&acc)[2][2][4][2], const Unit& u, int wr, int wc, int fr, int fq) const {
        const int row0 = u.pm * 256 + wr * 64 + fr, col0 = u.pn * 256 + wc * 32 + 4 * fq, b = (u.pm * 256) >> 12;
        f32x4 gv[2][2], gsv[2][2];
#pragma unroll
        for (int bj = 0; bj < 2; ++bj)
#pragma unroll
            for (int n = 0; n < 2; ++n) { gv[bj][n] = *(const f32x4*)(gate + b * 3072 + col0 + bj * 128 + n * 16) + 1.0f; gsv[bj][n] = *(const f32x4*)(gs + b * 1024 + col0 + bj * 128 + n * 16); }
#pragma unroll
        for (int ai = 0; ai < 2; ++ai)
#pragma unroll
            for (int m = 0; m < 4; ++m) {
                const int row = row0 + ai * 128 + m * 16; const size_t off = (size_t)row * 1024 + col0;
                float ssq = 0.f;
#pragma unroll
                for (int bj = 0; bj < 2; ++bj)
#pragma unroll
                    for (int n = 0; n < 2; ++n) {
                        const size_t o = off + bj * 128 + n * 16; const f32x4 r = *(const f32x4*)(res + o); const f32x4 x1 = r + gv[bj][n] * acc[ai][bj][m][n];
                        *(f32x4*)(out + o) = x1; ssq += x1.x * x1.x + x1.y * x1.y + x1.z * x1.z + x1.w * x1.w;
                        const f32x4 hv = x1 * gsv[bj][n]; u32x2 w; w.x = pk(hv.x, hv.y); w.y = pk(hv.z, hv.w); *(u32x2*)(Hn + o) = w;
                    }
                ssq += __shfl_xor(ssq, 16); ssq += __shfl_xor(ssq, 32);
                if (fq == 0) sred[(ai * 128 + wr * 64 + m * 16 + fr) * 4 + wc] = ssq;
            }
        __syncthreads();
        if (threadIdx.x < 256) { const f32x4 p = *(const f32x4*)(sred + threadIdx.x * 4); stats[(size_t)(u.pm * 256 + threadIdx.x) * 4 + u.pn] = (p.x + p.y) + (p.z + p.w); }
    }
};
struct EpiGate {
    static constexpr bool PERM = false, AFTER_DRAIN = false;
    bf16_t *UP, *G1;
    MK_DI void operator()(const f32x4 (&acc)[2][2][4][2], const Unit& u, int wr, int wc, int fr, int fq) const {
        const int row0 = u.pm * 256 + wr * 64 + fr, ch0 = u.pn * 64 + wc * 16 + 4 * fq;
#pragma unroll
        for (int ai = 0; ai < 2; ++ai)
#pragma unroll
            for (int m = 0; m < 4; ++m) {
                const size_t off = (size_t)(row0 + ai * 128 + m * 16) * 2048 + ch0;
                const f32x4 gb = acc[ai][0][m][0], gc = acc[ai][0][m][1], uu = acc[ai][1][m][0], gt = acc[ai][1][m][1];
                const f32x4 up = gc * uu;
                f32x4 gg; gg.x = gb.x * silu_f(gt.x); gg.y = gb.y * silu_f(gt.y); gg.z = gb.z * silu_f(gt.z); gg.w = gb.w * silu_f(gt.w);
                u32x2 w0, w1; w0.x = pk(up.x, up.y); w0.y = pk(up.z, up.w); w1.x = pk(gg.x, gg.y); w1.y = pk(gg.z, gg.w);
                *(u32x2*)(UP + off) = w0; *(u32x2*)(G1 + off) = w1;
            }
    }
};
struct EpiGateConv {
    static constexpr bool PERM = false, AFTER_DRAIN = false;
    bf16_t* Y1; float* US; float* GS; const float* cw; const float* cbias; const float* stats; const float* shW;
    MK_DI void operator()(const f32x4 (&acc)[2][2][4][2], const Unit& u, int wr, int wc, int fr, int fq) const {
        const int lane = fq * 16 + fr, row0 = u.pm * 256 + wr * 64 + fr, ch0 = u.pn * 64 + wc * 16 + 4 * fq;
        const float* sp = shW + ((u.pm * 256) >> 12) * 8192 + u.pn * 256 + wc * 32 + 4 * fq;
        const f32x4 s00 = *(const f32x4*)(sp), s01 = *(const f32x4*)(sp + 16), s10 = *(const f32x4*)(sp + 128), s11 = *(const f32x4*)(sp + 144);
        float rsv[2][4];
#pragma unroll
        for (int ai = 0; ai < 2; ++ai)
#pragma unroll
            for (int m = 0; m < 4; ++m) { const f32x4 p = *(const f32x4*)(stats + (size_t)(row0 + ai * 128 + m * 16) * 4); rsv[ai][m] = (p.x + p.y) + (p.z + p.w); }
        const f32x4 w0 = *(const f32x4*)(cw + ch0), w1 = *(const f32x4*)(cw + 2048 + ch0), w2 = *(const f32x4*)(cw + 4096 + ch0), cb = *(const f32x4*)(cbias + ch0);
        const int src1 = (lane & 48) | ((fr + 15) & 15), src2 = (lane & 48) | ((fr + 14) & 15);
#pragma unroll
        for (int ai = 0; ai < 2; ++ai) {
            const int grp = u.pm * 4 + ai * 2 + wr;
            f32x4 p1 = {0.f, 0.f, 0.f, 0.f}, p2 = {0.f, 0.f, 0.f, 0.f};
#pragma unroll
            for (int m = 0; m < 4; ++m) {
                const float rs = rsqrtf(rsv[ai][m] * (1.0f / 1024.0f) + EPS);
                const f32x4 gb = acc[ai][0][m][0] * rs + s00, gc = acc[ai][0][m][1] * rs + s01, uu = acc[ai][1][m][0] * rs + s10, gt = acc[ai][1][m][1] * rs + s11;
                const f32x4 up = gc * uu;
                f32x4 gg; gg.x = gb.x * silu_f(gt.x); gg.y = gb.y * silu_f(gt.y); gg.z = gb.z * silu_f(gt.z); gg.w = gb.w * silu_f(gt.w);
                f32x4 r1, r2;
                r1.x = __shfl(up.x, src1); r1.y = __shfl(up.y, src1); r1.z = __shfl(up.z, src1); r1.w = __shfl(up.w, src1);
                r2.x = __shfl(up.x, src2); r2.y = __shfl(up.y, src2); r2.z = __shfl(up.z, src2); r2.w = __shfl(up.w, src2);
                f32x4 um1 = r1, um2 = r2;
                if (m > 0) { if (fr == 0) um1 = p1; if (fr < 2) um2 = p2; }
                p1 = r1; p2 = r2;
                const f32x4 y = gg * (cb + w0 * um2 + w1 * um1 + w2 * up);
                u32x2 w; w.x = pk(y.x, y.y); w.y = pk(y.z, y.w);
                *(u32x2*)(Y1 + (size_t)(row0 + ai * 128 + m * 16) * 2048 + ch0) = w;
                if (m == 0 && fr < 2) { *(f32x4*)(US + (size_t)(grp * 4 + fr) * 2048 + ch0) = up; *(f32x4*)(GS + (size_t)(grp * 2 + fr) * 2048 + ch0) = gg; }
                if (m == 3 && fr >= 14) *(f32x4*)(US + (size_t)(grp * 4 + fr - 12) * 2048 + ch0) = up;
            }
        }
    }
};
struct EpiFold {
    static constexpr bool PERM = true, AFTER_DRAIN = false;
    bf16_t* W;
    MK_DI void operator()(const f32x4 (&acc)[2][2][4][2], const Unit& u, int wr, int wc, int fr, int fq) const {
        const int row0 = u.pm * 256 + wr * 64 + fr, cb = (u.pn & 3) * 256 + wc * 32 + 8 * fq;
#pragma unroll
        for (int ai = 0; ai < 2; ++ai)
#pragma unroll
            for (int m = 0; m < 4; ++m) {
                const int row = row0 + ai * 128 + m * 16;
#pragma unroll
                for (int bj = 0; bj < 2; ++bj) {
                    const f32x4 v0 = acc[ai][bj][m][0], v1 = acc[ai][bj][m][1];
                    u32x4 w; w.x = pk(v0.x, v0.y); w.y = pk(v0.z, v0.w); w.z = pk(v1.x, v1.y); w.w = pk(v1.z, v1.w);
                    *(u32x4*)(W + (size_t)row * 1024 + cb + bj * 128) = w;
                }
            }
    }
};
struct FoldSched {
    int G, c;
    __device__ bool next(int i, Unit& u) const { const int L = i * G + c; if (L >= 16) return false; u.pm = L >> 2; u.pn = L; return true; }
    MK_DI void a_ready(const Unit&) const {}
    MK_DI void done(const Unit&) const {}
};

MK_DI void p_pool_finish(const bf16_t* U, bf16_t* G, const float* pscale) {
    for (int item = blockIdx.x * NT + threadIdx.x; item < 1024 * 128; item += gridDim.x * NT) {
        const int chunk = item & 127, tb = item >> 7, g = chunk >> 5, w = 2 << g, t0 = tb * 32, pos0 = t0 & 4095;
        const bf16_t* up = U + (size_t)t0 * 1024 + chunk * 8;
        bf16_t* gp = G + (size_t)t0 * 2048 + chunk * 8;
        float s[8], ps[8];
#pragma unroll
        for (int i = 0; i < 8; ++i) { s[i] = 0.f; ps[i] = pscale[chunk * 8 + i]; }
        for (int i = 1; i < w; ++i) if (pos0 - i >= 0) { float f[8]; unpack8(*(const u32x4*)(up - (ptrdiff_t)i * 1024), f);
#pragma unroll
            for (int e = 0; e < 8; ++e) s[e] += f[e]; }
        for (int tt = 0; tt < 32; ++tt) {
            float cur[8], gg[8], p[8]; unpack8(*(const u32x4*)(up + (size_t)tt * 1024), cur); unpack8(*(const u32x4*)(gp + (size_t)tt * 2048), gg);
            const int cnt = (pos0 + tt + 1) < w ? (pos0 + tt + 1) : w; const float inv = 1.0f / (float)cnt;
#pragma unroll
            for (int e = 0; e < 8; ++e) { s[e] += cur[e]; p[e] = (s[e] * inv - cur[e]) * ps[e] * gg[e]; }
            *(u32x4*)(gp + (size_t)tt * 2048) = pack8(p);
            const int old = tt - (w - 1);
            if (pos0 + old >= 0) { float f[8]; unpack8(*(const u32x4*)(up + (ptrdiff_t)old * 1024), f);
#pragma unroll
                for (int e = 0; e < 8; ++e) s[e] -= f[e]; }
        }
    }
}

#define MK_MFMA32(a, b, c) __builtin_amdgcn_mfma_f32_32x32x16_bf16((a), (b), (c), 0, 0, 0)
MK_DI void p_attn(const bf16_t* Q, const bf16_t* Kh, const bf16_t* Vt, bf16_t* G) {
    const int tid = threadIdx.x, lane = lane_id(), wid = wave_id(), r = lane & 31, h = lane >> 5;
    const int pr = (r & 0x13) | ((r & 4) << 1) | ((r & 8) >> 1);
    for (int unit = blockIdx.x * 8 + wid; unit < 16384; unit += gridDim.x * 8) {
        const int qb = unit & 127, head = (unit >> 7) & 15, b = unit >> 11, q0 = qb * 32;
        const bf16_t* qp = Q + (size_t)(b * 4096 + q0 + r) * 1024 + head * 64 + 8 * h;
        bf16x8 qf[4];
#pragma unroll
        for (int kk = 0; kk < 4; ++kk) qf[kk] = *(const bf16x8*)(qp + 16 * kk);
        const bf16_t* kbase = Kh + ((size_t)(b * 16 + head) * 4096 + pr) * 64 + 8 * h;
        const bf16_t* vbase = Vt + (size_t)(head * 64 + r) * 32768 + b * 4096 + 8 * h;
        f32x16 o0, o1;
#pragma unroll
        for (int i = 0; i < 16; ++i) { o0[i] = 0.f; o1[i] = 0.f; }
        float carry = 1.0f;
        bf16x8 kf[4], vf[4], kf1[4], vf1[4];
#pragma unroll
        for (int kk = 0; kk < 4; ++kk) kf[kk] = *(const bf16x8*)(kbase + (size_t)q0 * 64 + 16 * kk);
#pragma unroll
        for (int i = 0; i < 4; ++i) vf[i] = *(const bf16x8*)(vbase + (size_t)(i >> 1) * 32 * 32768 + q0 + 16 * (i & 1));
        { const int kl1 = q0 >= 32 ? q0 - 32 : 0;
#pragma unroll
          for (int kk = 0; kk < 4; ++kk) kf1[kk] = *(const bf16x8*)(kbase + (size_t)kl1 * 64 + 16 * kk);
#pragma unroll
          for (int i = 0; i < 4; ++i) vf1[i] = *(const bf16x8*)(vbase + (size_t)(i >> 1) * 32 * 32768 + kl1 + 16 * (i & 1)); }
        int k0 = q0;
        for (;;) {
            const int k1 = k0 - 32, k2 = k0 - 64, kl = k2 < 0 ? 0 : k2;
            bf16x8 kn[4], vn[4];
#pragma unroll
            for (int kk = 0; kk < 4; ++kk) kn[kk] = *(const bf16x8*)(kbase + (size_t)kl * 64 + 16 * kk);
#pragma unroll
            for (int i = 0; i < 4; ++i) vn[i] = *(const bf16x8*)(vbase + (size_t)(i >> 1) * 32 * 32768 + kl + 16 * (i & 1));
            f32x16 z;
#pragma unroll
            for (int i = 0; i < 16; ++i) z[i] = 0.f;
#pragma unroll
            for (int kk = 0; kk < 4; ++kk) z = MK_MFMA32(kf[kk], qf[kk], z);
            const bool diag = (k0 == q0);
            float ez[16], cf[16];
#pragma unroll
            for (int i = 0; i < 16; ++i) {
                const int krel = 16 * (i >> 3) + 8 * h + (i & 7);
                float zz = fminf(z[i], 100.0f);
                if (diag && krel >= r) zz = -__builtin_inff();
                ez[i] = __builtin_amdgcn_exp2f(zz);
                cf[i] = __builtin_amdgcn_rcpf(1.0f + ez[i]);
            }
#pragma unroll
            for (int i = 6; i >= 0; --i) { cf[i] *= cf[i + 1]; cf[i + 8] *= cf[i + 9]; }
            const float plo = cf[0], phi = cf[8];
            const float plo_p = __shfl_xor(plo, 32), phi_p = __shfl_xor(phi, 32);
            const float pre_hi = carry * (h == 0 ? phi_p : 1.0f);
            const float pre_lo = carry * (phi * phi_p) * (h == 0 ? plo_p : 1.0f);
            carry = carry * (plo * plo_p) * (phi * phi_p);
            float a[16];
#pragma unroll
            for (int i = 0; i < 8; ++i) { a[i] = (ez[i] * cf[i]) * pre_lo; a[i + 8] = (ez[i + 8] * cf[i + 8]) * pre_hi; }
            u32x4 w0, w1;
            w0.x = pk(a[0], a[1]); w0.y = pk(a[2], a[3]); w0.z = pk(a[4], a[5]); w0.w = pk(a[6], a[7]);
            w1.x = pk(a[8], a[9]); w1.y = pk(a[10], a[11]); w1.z = pk(a[12], a[13]); w1.w = pk(a[14], a[15]);
            const bf16x8 p0 = __builtin_bit_cast(bf16x8, w0), p1 = __builtin_bit_cast(bf16x8, w1);
            o0 = MK_MFMA32(vf[0], p0, o0); o0 = MK_MFMA32(vf[1], p1, o0);
            o1 = MK_MFMA32(vf[2], p0, o1); o1 = MK_MFMA32(vf[3], p1, o1);
            if (k1 < 0) break;
            if (__all(carry < 1e-37f)) break;
#pragma unroll
            for (int i = 0; i < 4; ++i) { kf[i] = kf1[i]; vf[i] = vf1[i]; kf1[i] = kn[i]; vf1[i] = vn[i]; }
            k0 = k1;
        }
        bf16_t* gp = G + (size_t)(b * 4096 + q0 + r) * 2048 + 1024 + head * 64 + 4 * h;
#pragma unroll
        for (int g4 = 0; g4 < 4; ++g4) {
            { u32x2* p = (u32x2*)(gp + 8 * g4); const u32x2 gw = *p; u32x2 w;
              w.x = pk(o0[4 * g4] * bflo(gw.x), o0[4 * g4 + 1] * bfhi(gw.x)); w.y = pk(o0[4 * g4 + 2] * bflo(gw.y), o0[4 * g4 + 3] * bfhi(gw.y)); *p = w; }
            { u32x2* p = (u32x2*)(gp + 32 + 8 * g4); const u32x2 gw = *p; u32x2 w;
              w.x = pk(o1[4 * g4] * bflo(gw.x), o1[4 * g4 + 1] * bfhi(gw.x)); w.y = pk(o1[4 * g4 + 2] * bflo(gw.y), o1[4 * g4 + 3] * bfhi(gw.y)); *p = w; }
        }
    }
}

MK_DI void p_conv(const bf16_t* UP, bf16_t* G1, const float* cw, const float* cbias) {
    for (int item = blockIdx.x * NT + threadIdx.x; item < 2048 * 256; item += gridDim.x * NT) {
        const int chunk = item & 255, tb = item >> 8, t0 = tb * 16, pos0 = t0 & 4095, c0 = chunk * 8;
        float w0[8], w1[8], w2[8], bb[8], um2[8], um1[8];
#pragma unroll
        for (int e = 0; e < 8; ++e) { w0[e] = cw[c0 + e]; w1[e] = cw[2048 + c0 + e]; w2[e] = cw[4096 + c0 + e]; bb[e] = cbias[c0 + e]; um2[e] = 0.f; um1[e] = 0.f; }
        const bf16_t* up = UP + (size_t)t0 * 2048 + c0; bf16_t* gp = G1 + (size_t)t0 * 2048 + c0;
        if (pos0 != 0) { unpack8(*(const u32x4*)(up - 4096), um2); unpack8(*(const u32x4*)(up - 2048), um1); }
        for (int tt = 0; tt < 16; ++tt) {
            float cur[8], gg[8], y[8];
            unpack8(*(const u32x4*)(up + (size_t)tt * 2048), cur); unpack8(*(const u32x4*)(gp + (size_t)tt * 2048), gg);
#pragma unroll
            for (int e = 0; e < 8; ++e) { y[e] = gg[e] * (bb[e] + w0[e] * um2[e] + w1[e] * um1[e] + w2[e] * cur[e]); um2[e] = um1[e]; um1[e] = cur[e]; }
            *(u32x4*)(gp + (size_t)tt * 2048) = pack8(y);
        }
    }
}

MK_DI void p_fixup(const float* US, const float* GS, const float* cw, const float* cbias, bf16_t* Y1) {
    for (int item = blockIdx.x * NT + threadIdx.x; item < 512 * 2 * 512; item += gridDim.x * NT) {
        const int c4 = (item & 511) * 4, i = (item >> 9) & 1, grp = item >> 10;
        const bool first = (grp & 63) == 0;
        const f32x4 zero = {0.f, 0.f, 0.f, 0.f};
        const f32x4 cur = *(const f32x4*)(US + (size_t)(grp * 4 + i) * 2048 + c4), gg = *(const f32x4*)(GS + (size_t)(grp * 2 + i) * 2048 + c4);
        f32x4 um1, um2;
        if (i == 0) { um1 = first ? zero : *(const f32x4*)(US + (size_t)((grp - 1) * 4 + 3) * 2048 + c4); um2 = first ? zero : *(const f32x4*)(US + (size_t)((grp - 1) * 4 + 2) * 2048 + c4); }
        else        { um1 = *(const f32x4*)(US + (size_t)(grp * 4) * 2048 + c4);                          um2 = first ? zero : *(const f32x4*)(US + (size_t)((grp - 1) * 4 + 3) * 2048 + c4); }
        const f32x4 w0 = *(const f32x4*)(cw + c4), w1 = *(const f32x4*)(cw + 2048 + c4), w2 = *(const f32x4*)(cw + 4096 + c4), cb = *(const f32x4*)(cbias + c4);
        const f32x4 y = gg * (cb + w0 * um2 + w1 * um1 + w2 * cur);
        u32x2 w; w.x = pk(y.x, y.y); w.y = pk(y.z, y.w);
        *(u32x2*)(Y1 + (size_t)(grp * 64 + i) * 2048 + c4) = w;
    }
}

template <class Epi> MK_DI void run_gemm(PG8_LAS unsigned char* lds, const bf16_t* A, const bf16_t* Bt, int Mr, int Nc, int K, const Epi& E) {
    Gemm g; g.A = A; g.Bt = Bt; g.M = Mr; g.N = Nc; g.K = K;
    pg8::StaticOrder so; so.init(Mr, Nc, (int)gridDim.x, (int)blockIdx.x);
    pg8::gemm_phase<Epi, pg8::StaticOrder, true, true>(lds, g, so, E);
}

__global__ void __launch_bounds__(512, 2) mk_fwd(Args a) {
    extern __shared__ __attribute__((aligned(16))) unsigned char smem[];
    cg::grid_group grid = cg::this_grid();
    PG8_LAS unsigned char* lds = (PG8_LAS unsigned char*)smem;
    float* smf = (float*)smem;
    unsigned char* ws = a.ws;
    const int lo = a.ph_lo, hi = a.ph_hi;
    float* mod = (float*)(ws + WS_MOD);
    bf16_t* H = (bf16_t*)(ws + WS_H);
    bf16_t *U = (bf16_t*)(ws + WS_U), *Q = (bf16_t*)(ws + WS_Q), *Kh = (bf16_t*)(ws + WS_K), *Vt = (bf16_t*)(ws + WS_VT), *G = (bf16_t*)(ws + WS_G);
    bf16_t *UP = (bf16_t*)(ws + WS_UP), *G1 = (bf16_t*)(ws + WS_G1);
#define MK_IN(k) (lo <= (k) && (k) < hi)
    volatile LAS unsigned* xst = (volatile LAS unsigned*)(lds + 131072);
    if (threadIdx.x < 4) xst[threadIdx.x] = 0u;
    __syncthreads();
    XcdBarrier xbar = xcd_barrier_post((unsigned*)(ws + WS_BAR), xst);
    if (lo < 0) grid.sync();
#define MK_SEAM(k) do { if (MK_IN(k) && MK_IN((k) + 1)) xcd_barrier(xbar); } while (0)
    if (MK_IN(0)) { p0_adaln(a.in[1], a.in[3], a.in[4], mod, smf); p0_transpose(a, smf); }
    MK_SEAM(0);
    float* stats = (float*)(ws + WS_STATS); float* gs = (float*)(ws + WS_GS); float* shW = (float*)(ws + WS_SHW);
    if (MK_IN(1)) { p1_side(a.in[2] + 1024, mod + 8 * 3072, (const bf16_t*)(ws + WS_W1), gs, stats, shW, smf); p_norm_mod(a.in[0], a.in[2], mod, H); }
    if (MK_IN(1) && blockIdx.x < 16) {
        EpiFold e; e.W = (bf16_t*)(ws + WS_W0A);
        Gemm g; g.A = (const bf16_t*)(ws + WS_WP); g.Bt = (const bf16_t*)(ws + WS_WINP); g.M = 1024; g.N = 4096; int kf = 256; asm volatile("" : "+s"(kf)); g.K = kf;
        FoldSched fs; fs.G = (int)gridDim.x; fs.c = (int)blockIdx.x;
        pg8::gemm_phase<EpiFold, FoldSched, true, true>(lds, g, fs, e);
    }
    MK_SEAM(1);
    if (MK_IN(2)) {
        EpiProj0 e0; e0.U = U; e0.Q = Q; e0.Kh = Kh; e0.G = G;
        run_gemm(lds, H, (const bf16_t*)(ws + WS_W0A), M, 5120, 1024, e0);
        EpiVt e1; e1.Vt = Vt;
        run_gemm(lds, (const bf16_t*)(ws + WS_WV), H, 1024, M, 1024, e1);
    }
    MK_SEAM(2);
    if (MK_IN(3)) { p_attn(Q, Kh, Vt, G); p_pool_finish(U, G, a.in[7]); }
    MK_SEAM(3);
    if (MK_IN(5)) { EpiResNorm e; e.res = a.in[0]; e.out = a.out; e.gate = mod + 2048; e.gs = gs; e.Hn = H; e.stats = stats; e.sred = (float*)(smem + 131072 + 16); run_gemm(lds, G, (const bf16_t*)(ws + WS_WO0), M, 1024, 2048, e); }
    MK_SEAM(5);
    float* US = (float*)(ws + WS_UP); float* GS = (float*)(ws + WS_UP + 16 * MiB);
    if (MK_IN(7)) { EpiGateConv e; e.Y1 = G1; e.US = US; e.GS = GS; e.cw = a.in[10]; e.cbias = a.in[11]; e.stats = stats; e.shW = shW; run_gemm(lds, H, (const bf16_t*)(ws + WS_W1), M, 8192, 1024, e); }
    MK_SEAM(7);
    if (MK_IN(8)) p_fixup(US, GS, a.in[10], a.in[11], G1);
    MK_SEAM(8);
    if (MK_IN(9)) { EpiRes e; e.res = a.out; e.out = a.out; e.gate = mod + 8 * 3072 + 2048; run_gemm(lds, G1, (const bf16_t*)(ws + WS_WO1), M, 1024, 2048, e); }
    MK_SEAM(9);
    if (MK_IN(10)) p_final_norm(a.out, a.in[13]);
}
}

#ifndef MK_ONE_LAUNCH
#define MK_ONE_LAUNCH 1
#endif
constexpr int MK_LDS_BYTES = 131072 + 16 + 4096;
extern "C" void kernel_launch(void* const* d_in, const int* in_sizes, int n_in, void* d_out, int out_size, void* d_ws, size_t ws_size, hipStream_t stream) {
    static int grid = 0;
    if (grid == 0) {
        if (n_in != 14 || out_size != mk::M * mk::D || ws_size < mk::WS_END2) { fprintf(stderr, "kernel_launch: unexpected shapes (n_in %d, out %d, ws %zu < %zu)\n", n_in, out_size, ws_size, (size_t)mk::WS_END2); grid = -1; return; }
        int dev = 0, cus = 0, per_cu = 0;
        if (hipGetDevice(&dev) != hipSuccess || hipDeviceGetAttribute(&cus, hipDeviceAttributeMultiprocessorCount, dev) != hipSuccess) { grid = -1; return; }
        if (hipFuncSetAttribute((const void*)mk::mk_fwd, hipFuncAttributeMaxDynamicSharedMemorySize, MK_LDS_BYTES) != hipSuccess) { fprintf(stderr, "kernel_launch: hipFuncSetAttribute failed\n"); grid = -1; return; }
        if (hipOccupancyMaxActiveBlocksPerMultiprocessor(&per_cu, (const void*)mk::mk_fwd, 512, MK_LDS_BYTES) != hipSuccess || per_cu < 1) { per_cu = 1; (void)hipGetLastError(); }
        grid = cus;
    }
    if (grid < 0) return;
    if (hipMemsetAsync((char*)d_ws + mk::WS_BAR, 0, XCD_BAR_WORDS * sizeof(unsigned), stream) != hipSuccess) { fprintf(stderr, "kernel_launch: memset of barrier words failed\n"); return; }
    mk::Args a{};
    for (int i = 0; i < 14; ++i) a.in[i] = (const float*)d_in[i];
    a.out = (float*)d_out; a.ws = (unsigned char*)d_ws;
#if MK_ONE_LAUNCH
    a.ph_lo = 0; a.ph_hi = 11;
    void* args[] = {&a};
    hipError_t e = hipLaunchCooperativeKernel((const void*)mk::mk_fwd, dim3(grid), dim3(512), args, MK_LDS_BYTES, stream);
    if (e != hipSuccess) fprintf(stderr, "kernel_launch: cooperative launch failed: %s (grid %d)\n", hipGetErrorString(e), grid);
#else
    for (int ph = 0; ph < 11; ++ph) { a.ph_lo = ph; a.ph_hi = ph + 1; hipLaunchKernelGGL(mk::mk_fwd, dim3(grid), dim3(512), MK_LDS_BYTES, stream, a); }
#endif
}
```
